# Optimizing an MI355X kernel written in HIP

```python
import jax, jax.numpy as jnp
from jax import lax
import numpy as np

D_MODEL = 1024
BATCH = 2
SEQ = 16384
DEPTH = 2

GRID_W = 64
CTX_LEN = 256
HEAD_DIM = 128
A_HEADS = 4
A_KV_HEADS = 2
B_HEADS = 4
B_KV_HEADS = 2
Q_WIDTH = (A_HEADS + B_HEADS) * HEAD_DIM
KV_WIDTH = 2 * (A_KV_HEADS + B_KV_HEADS) * HEAD_DIM
BLOCK = 128
WINDOW = 128
ROPE_THETA = 10000.0
FNET_GROUPS = 4
D_FF = 2816
CONV_W = 3
N_MOD = 6
N_ATTN_LAYERS = (DEPTH + 1) // 2
N_FOURIER_LAYERS = DEPTH // 2
EPS = 1e-6

kernel_name = "hybrid_dit_attn_fnet_convffn"

F32 = jnp.float32


def rms_norm(x, g):
    xf = x.astype(F32)
    y = xf * lax.rsqrt(jnp.mean(xf * xf, axis=-1, keepdims=True) + EPS)
    return (y * g.astype(F32)).astype(x.dtype)


def modulate(h, shift, scale):
    return h * (1 + scale) + shift


def adaln_params(cond, w, bias):
    m = jax.nn.silu(cond) @ w + bias
    return jnp.split(m[..., None, :], N_MOD, axis=-1)


def axial_rope_tables(row, col):
    n_freq = HEAD_DIM // 4
    inv = ROPE_THETA ** (-jnp.arange(n_freq, dtype=F32) / n_freq)
    ang = jnp.stack([row.astype(F32)[:, None] * inv, col.astype(F32)[:, None] * inv], axis=1)
    return jnp.cos(ang), jnp.sin(ang)


def apply_rope(x, cos, sin):
    b, l, h, dh = x.shape
    xs = x.reshape(b, l, h, 2, 2, dh // 4)
    x1, x2 = xs[..., 0, :], xs[..., 1, :]
    cs = cos[None, :, None].astype(x.dtype)
    sn = sin[None, :, None].astype(x.dtype)
    out = jnp.stack([x1 * cs - x2 * sn, x2 * cs + x1 * sn], axis=-2)
    return out.reshape(b, l, h, dh)


def group_heads(q, n_kv):
    b, l, h, dh = q.shape
    return q.reshape(b, l, n_kv, h // n_kv, dh)


def split_kv(kv):
    b, l, _ = kv.shape
    a = A_KV_HEADS * HEAD_DIM
    bb = B_KV_HEADS * HEAD_DIM
    k_a, v_a, k_b, v_b = jnp.split(kv, [a, 2 * a, 2 * a + bb], axis=-1)
    return (k_a.reshape(b, l, A_KV_HEADS, HEAD_DIM), v_a.reshape(b, l, A_KV_HEADS, HEAD_DIM),
            k_b.reshape(b, l, B_KV_HEADS, HEAD_DIM), v_b.reshape(b, l, B_KV_HEADS, HEAD_DIM))


def attend(q, k, v, sink=None):
    s = jnp.einsum('bqkgd,bskd->bkgqs', q, k, preferred_element_type=F32) * (HEAD_DIM ** -0.5)
    if sink is not None:
        s_sink = jnp.broadcast_to(sink.astype(F32)[None, :, :, None, None], s.shape[:-1] + (1,))
        p = jax.nn.softmax(jnp.concatenate([s_sink, s], axis=-1), axis=-1)[..., 1:]
    else:
        p = jax.nn.softmax(s, axis=-1)
    return jnp.einsum('bkgqs,bskd->bqkgd', p.astype(v.dtype), v)


def global_attention(q, k, v, k_ctx, v_ctx):
    b, l, hkv, g, dh = q.shape
    k_all = jnp.concatenate([k_ctx, k], axis=1)
    v_all = jnp.concatenate([v_ctx, v], axis=1)
    qb = jnp.moveaxis(q.reshape(b, l // BLOCK, BLOCK, hkv, g, dh), 1, 0)
    o = lax.map(lambda qblk: attend(qblk, k_all, v_all), qb)
    return jnp.moveaxis(o, 0, 1).reshape(b, l, hkv * g * dh)


def window_attention(q, k, v, k_ctx, v_ctx, sink):
    b, l, hkv, g, dh = q.shape
    nb = l // BLOCK
    zpad = jnp.zeros((b, BLOCK, hkv, dh), k.dtype)

    def band(t):
        tp = jnp.concatenate([zpad, t, zpad], axis=1).reshape(b, nb + 2, BLOCK, hkv, dh)
        return jnp.concatenate([tp[:, :-2], tp[:, 1:-1], tp[:, 2:]], axis=2)

    kb, vb = band(k), band(v)
    qb = q.reshape(b, nb, BLOCK, hkv, g, dh)
    scale = HEAD_DIM ** -0.5
    s_loc = jnp.einsum('bnqkgd,bnskd->bnkgqs', qb, kb, preferred_element_type=F32) * scale
    s_ctx = jnp.einsum('bnqkgd,bskd->bnkgqs', qb, k_ctx, preferred_element_type=F32) * scale
    qi = jnp.arange(BLOCK)[:, None]
    si = jnp.arange(3 * BLOCK)[None, :]
    in_window = jnp.abs(si - BLOCK - qi) <= WINDOW
    kpos = (jnp.arange(nb)[:, None] - 1) * BLOCK + jnp.arange(3 * BLOCK)[None, :]
    in_range = (kpos >= 0) & (kpos < l)
    valid = in_window[None] & in_range[:, None, :]
    s_loc = jnp.where(valid[None, :, None, None], s_loc, -jnp.inf)
    s_sink = jnp.broadcast_to(sink.astype(F32)[None, None, :, :, None, None], s_ctx.shape[:-1] + (1,))
    p = jax.nn.softmax(jnp.concatenate([s_sink, s_ctx, s_loc], axis=-1), axis=-1)
    c_len = k_ctx.shape[1]
    p_ctx = p[..., 1:1 + c_len].astype(v.dtype)
    p_loc = p[..., 1 + c_len:].astype(v.dtype)
    o = (jnp.einsum('bnkgqs,bskd->bnqkgd', p_ctx, v_ctx)
         + jnp.einsum('bnkgqs,bnskd->bnqkgd', p_loc, vb))
    return o.reshape(b, l, hkv * g * dh)


def attention_mixers(h, hc, w_in, w_out, q_g, k_g, sink, cos, sin, with_ctx_queries):
    b, l, _ = h.shape
    c_len = hc.shape[1]
    proj = h @ w_in
    q_all, kv = proj[..., :Q_WIDTH], proj[..., Q_WIDTH:]
    q_a = q_all[..., :A_HEADS * HEAD_DIM].reshape(b, l, A_HEADS, HEAD_DIM)
    q_b = q_all[..., A_HEADS * HEAD_DIM:].reshape(b, l, B_HEADS, HEAD_DIM)
    k_a, v_a, k_b, v_b = split_kv(kv)
    q_a = apply_rope(rms_norm(q_a, q_g), cos, sin)
    k_a = apply_rope(rms_norm(k_a, k_g), cos, sin)
    q_b = apply_rope(q_b, cos, sin)
    k_b = apply_rope(k_b, cos, sin)
    k_ac, v_ac, k_bc, v_bc = split_kv(hc @ w_in[:, Q_WIDTH:])
    k_ac = rms_norm(k_ac, k_g)
    sink_hg = sink.reshape(B_KV_HEADS, B_HEADS // B_KV_HEADS)
    o_a = global_attention(group_heads(q_a, A_KV_HEADS), k_a, v_a, k_ac, v_ac)
    o_b = window_attention(group_heads(q_b, B_KV_HEADS), k_b, v_b, k_bc, v_bc, sink_hg)
    y = jnp.concatenate([o_a, o_b], axis=-1) @ w_out
    if not with_ctx_queries:
        return y, None
    qc = hc @ w_in[:, :Q_WIDTH]
    qc_a = rms_norm(qc[..., :A_HEADS * HEAD_DIM].reshape(b, c_len, A_HEADS, HEAD_DIM), q_g)
    qc_b = qc[..., A_HEADS * HEAD_DIM:].reshape(b, c_len, B_HEADS, HEAD_DIM)
    oc_a = attend(group_heads(qc_a, A_KV_HEADS), k_ac, v_ac).reshape(b, c_len, -1)
    oc_b = attend(group_heads(qc_b, B_KV_HEADS), k_bc, v_bc, sink_hg).reshape(b, c_len, -1)
    yc = jnp.concatenate([oc_a, oc_b], axis=-1) @ w_out
    return y, yc


def fourier_mix(h):
    b, l, d = h.shape
    hg = h.reshape(b, l, FNET_GROUPS, d // FNET_GROUPS).astype(F32)
    f = jnp.fft.fft2(hg, axes=(1, 3), norm="ortho").real
    return f.reshape(b, l, d).astype(h.dtype)


def conv_ffn(h, w_up, conv_w, conv_b, w_down):
    u = h @ w_up
    up = jnp.pad(u, ((0, 0), (1, 1), (0, 0)))
    u = up[:, :-2] * conv_w[0] + up[:, 1:-1] * conv_w[1] + up[:, 2:] * conv_w[2] + conv_b
    gate, val = jnp.split(u, 2, axis=-1)
    return (jax.nn.silu(gate) * val) @ w_down


def setup_inputs(seed: int = 0) -> dict:
    key = jax.random.key(seed)
    ks = jax.random.split(key, 17)

    def nrm(k, shape, scale):
        return jax.random.normal(k, shape, F32) * scale

    return {
        "x": nrm(ks[0], (BATCH, SEQ, D_MODEL), 1.0),
        "c": nrm(ks[1], (BATCH, D_MODEL), 1.0),
        "ctx": nrm(ks[2], (BATCH, CTX_LEN, D_MODEL), 1.0),
        "c_ctx": nrm(ks[3], (D_MODEL,), 1.0),
        "mod_w": nrm(ks[4], (DEPTH, D_MODEL, N_MOD * D_MODEL), 0.5 * D_MODEL ** -0.5),
        "mod_b": nrm(ks[5], (DEPTH, N_MOD * D_MODEL), 0.02),
        "norm_g": 1.0 + nrm(ks[6], (DEPTH, 4, D_MODEL), 0.02),
        "attn_w_in": nrm(ks[7], (N_ATTN_LAYERS, D_MODEL, Q_WIDTH + KV_WIDTH), D_MODEL ** -0.5),
        "attn_w_out": nrm(ks[8], (N_ATTN_LAYERS, Q_WIDTH, D_MODEL), Q_WIDTH ** -0.5),
        "q_norm_g": 1.0 + nrm(ks[9], (N_ATTN_LAYERS, HEAD_DIM), 0.02),
        "k_norm_g": 1.0 + nrm(ks[10], (N_ATTN_LAYERS, HEAD_DIM), 0.02),
        "sink": nrm(ks[11], (N_ATTN_LAYERS, B_HEADS), 0.5),
        "fourier_w_out": nrm(ks[12], (N_FOURIER_LAYERS, D_MODEL, D_MODEL), D_MODEL ** -0.5),
        "ffn_w_up": nrm(ks[13], (DEPTH, D_MODEL, 2 * D_FF), D_MODEL ** -0.5),
        "ffn_conv_w": nrm(ks[14], (DEPTH, CONV_W, 2 * D_FF), CONV_W ** -0.5),
        "ffn_conv_b": nrm(ks[15], (DEPTH, 2 * D_FF), 0.02),
        "ffn_w_down": nrm(ks[16], (DEPTH, D_FF, D_MODEL), D_FF ** -0.5),
    }


def reference(x, c, ctx, c_ctx, mod_w, mod_b, norm_g, attn_w_in, attn_w_out, q_norm_g, k_norm_g, sink,
              fourier_w_out, ffn_w_up, ffn_conv_w, ffn_conv_b, ffn_w_down):
    b, l, d = x.shape
    rows = l // GRID_W
    row = jnp.repeat(jnp.arange(rows), GRID_W)
    col = jnp.tile(jnp.arange(GRID_W), rows)
    cos, sin = axial_rope_tables(row, col)

    for i in range(DEPTH):
        ctx_next = any(j % 2 == 0 for j in range(i + 1, DEPTH))
        need_hc = (i % 2 == 0) or ctx_next
        sh1, sc1, g1, sh2, sc2, g2 = adaln_params(c, mod_w[i], mod_b[i])
        h = modulate(rms_norm(x, norm_g[i, 0]), sh1, sc1)
        if need_hc:
            csh1, csc1, cg1, csh2, csc2, cg2 = adaln_params(c_ctx, mod_w[i], mod_b[i])
            hc = modulate(rms_norm(ctx, norm_g[i, 0]), csh1, csc1)
        if i % 2 == 0:
            a = i // 2
            y, yc = attention_mixers(h, hc, attn_w_in[a], attn_w_out[a], q_norm_g[a], k_norm_g[a], sink[a],
                                     cos, sin, ctx_next)
        else:
            w_f = fourier_w_out[i // 2]
            y = fourier_mix(h) @ w_f
            yc = fourier_mix(hc) @ w_f if ctx_next else None
        x = x + g1 * rms_norm(y, norm_g[i, 1])
        h = modulate(rms_norm(x, norm_g[i, 2]), sh2, sc2)
        x = x + g2 * rms_norm(conv_ffn(h, ffn_w_up[i], ffn_conv_w[i], ffn_conv_b[i], ffn_w_down[i]), norm_g[i, 3])
        if ctx_next:
            ctx = ctx + cg1 * rms_norm(yc, norm_g[i, 1])
            hc = modulate(rms_norm(ctx, norm_g[i, 2]), csh2, csc2)
            ctx = ctx + cg2 * rms_norm(conv_ffn(hc, ffn_w_up[i], ffn_conv_w[i], ffn_conv_b[i], ffn_w_down[i]),
                                       norm_g[i, 3])
    return x
```

```cpp
#include <hip/hip_runtime.h>
#include <hip/hip_cooperative_groups.h>
#include <cstdio>
#include <cstdint>
namespace cg = cooperative_groups;
#ifndef CONV_ALIGNED
#define CONV_ALIGNED 1
#endif
#ifndef ATT_FIXMAX
#define ATT_FIXMAX 1
#endif
#ifndef CTX_IN_P3
#define CTX_IN_P3 1
#endif
#ifndef HERM
#define HERM 1
#endif
#ifndef RES_ROWS
#define RES_ROWS 2
#endif
#ifndef FUSE_QKV
#define FUSE_QKV 0
#endif

constexpr int DM = 1024, NB = 2, SEQ = 16384, CTXL = 256, HD = 128;
constexpr int MTOK = NB * SEQ;
constexpr int MALL = MTOK + NB * CTXL;
constexpr int DFF = 2816, NUP = 2 * DFF;
constexpr int SKV = CTXL + SEQ;
constexpr int NPROJ = 2048;
constexpr float EPS = 1e-6f;
constexpr int NTILE_UP = 130;
constexpr size_t MiB = 1u << 20;
constexpr size_t WS_MOD = 0;
constexpr size_t WS_ROPE = 256 * 1024;
constexpr size_t WS_TW = 512 * 1024;
constexpr size_t WS_DFTW = 768 * 1024;
constexpr size_t WS_CTL = 896 * 1024;
constexpr size_t WS_WIN = 1 * MiB, WS_WOUT = 5 * MiB, WS_WP = 7 * MiB, WS_WUP0 = 11 * MiB, WS_WUP1 = 22 * MiB, WS_WDN0 = 33 * MiB, WS_WDN1 = 39 * MiB;
constexpr size_t WS_XN = 46 * MiB + 4096;
constexpr size_t WS_Y = 112 * MiB;
constexpr size_t WS_BIG = 176 * MiB;
constexpr size_t WS_PROJ = WS_BIG;
constexpr size_t WS_Q = WS_BIG + 130 * MiB;
constexpr size_t KV_BYTES = (size_t)NB * 2 * SKV * HD * 2;
constexpr size_t WS_KA = WS_Q + 64 * MiB, WS_VA = WS_KA + KV_BYTES, WS_KB = WS_VA + KV_BYTES, WS_VB = WS_KB + KV_BYTES;
constexpr size_t WS_O = WS_BIG;
constexpr size_t WS_ACT = WS_BIG;
constexpr size_t WS_Y1R = WS_BIG, WS_Y1I = WS_BIG + 64 * MiB;
constexpr size_t WS_A2 = WS_BIG + 128 * MiB;
constexpr size_t WS_XRES = 440 * MiB;
constexpr size_t WS_EDGE = 504 * MiB;
constexpr size_t WS_WC = WS_WP, WS_WS = WS_WP + 2 * MiB;
constexpr size_t WS_XR = WS_A2, WS_XI = WS_A2 + 32 * MiB;
constexpr size_t WS_YNY = 192 * 1024;
constexpr size_t WS_END = WS_EDGE + (size_t)128 * 4 * NUP * 2;
static_assert(WS_END <= 512 * MiB && WS_A2 + (size_t)MTOK * 2048 * 2 <= WS_XRES && WS_VB + KV_BYTES <= WS_XRES, "ws map");
constexpr int LDS_XCH = 131072;
constexpr int LDS_MISC = 139264;
constexpr int LDS_BYTES = 147456;

typedef unsigned short bf16_t;
typedef short bf16x8 __attribute__((ext_vector_type(8)));
typedef short s16x4 __attribute__((ext_vector_type(4)));
typedef float f32x4 __attribute__((ext_vector_type(4)));
typedef float f32x2 __attribute__((ext_vector_type(2)));
typedef float f32x16 __attribute__((ext_vector_type(16)));
typedef unsigned u32x4 __attribute__((ext_vector_type(4)));
typedef unsigned u32x2 __attribute__((ext_vector_type(2)));
#define LAS __attribute__((address_space(3)))

typedef __bf16 bf16x2_t __attribute__((ext_vector_type(2)));
__device__ __forceinline__ unsigned cvt_pk_bf16(float lo, float hi) { f32x2 v = {lo, hi}; bf16x2_t b = __builtin_convertvector(v, bf16x2_t); return __builtin_bit_cast(unsigned, b); }
__device__ __forceinline__ float bf_lo(unsigned w) { return __uint_as_float(w << 16); }
__device__ __forceinline__ float bf_hi(unsigned w) { return __uint_as_float(w & 0xffff0000u); }
__device__ __forceinline__ bf16_t f2bf(float f) { return (bf16_t)(cvt_pk_bf16(f, 0.f) & 0xffffu); }
__device__ __forceinline__ float wave_sum(float v) {
#pragma unroll
    for (int o = 1; o < 64; o <<= 1) v += __shfl_xor(v, o);
    return v;
}

namespace pg8 {
#define PG8_LAS __attribute__((address_space(3)))
typedef unsigned short bf16_t;
typedef short bf16x8 __attribute__((ext_vector_type(8)));
typedef float f32x4 __attribute__((ext_vector_type(4)));
typedef unsigned u32x4 __attribute__((ext_vector_type(4)));
constexpr int BM = 256, BK = 64, HALF = 128, HTB = HALF * BK * 2  , STAGE_BYTES = 8 * HTB, NXCD = 8, WGM = 8;

__host__ __device__ __forceinline__ int lds_byte(int r, int c) { const int st = (r >> 4) * 2 + (c >> 5), rr = r & 15, cc = c & 31, ob = rr * 64 + cc * 2; return st * 1024 + (ob ^ (((ob >> 9) & 1) << 5)); }
__host__ __device__ __forceinline__ void stage_rc(int b, int& R, int& C) { const int st = b / 1024, sb = b % 1024, swz = sb ^ (((sb >> 9) & 1) << 5); R = (st >> 1) * 16 + swz / 64; C = (st & 1) * 32 + (swz % 64) / 2; }
__host__ __device__ __forceinline__ int perm32(int rho) { const int n = rho >> 4, i = rho & 15; return 8 * (i >> 2) + 4 * n + (i & 3); }

struct Unit { int pm, pn; };
struct Gemm { const bf16_t* A; const bf16_t* Bt; int K; int a_rows; int msplit = 1 << 30; size_t bsplit = 0; };

struct StaticOrder {
    int nM, nN, nwg, G, c; int fpm = -1, fpn = 0;
    __host__ __device__ void init(int nM_, int nN_, int G_, int c_) { nM = nM_; nN = nN_; nwg = nM * nN; G = G_; c = c_; }
    __host__ __device__ bool next(int i, Unit& u) const {
        if (fpm >= 0) { if (i) return false; u.pm = fpm; u.pn = fpn; return true; }
        const long L = (long)i * G + c; if (L >= nwg) return false;
        int wgid = (int)L; { const int q = nwg / NXCD, r = nwg % NXCD, xcd = wgid % NXCD, off = wgid / NXCD; wgid = (xcd < r ? xcd * (q + 1) : r * (q + 1) + (xcd - r) * q) + off; }
        const int nig = WGM * nN, gid = wgid / nig, fm = gid * WGM, gsz = (nM - fm) < WGM ? (nM - fm) : WGM;
        u.pm = fm + ((wgid % nig) % gsz); u.pn = (wgid % nig) / gsz; return true;
    }
    __device__ __forceinline__ void a_ready(const Unit&) const {}
    __device__ __forceinline__ void done(const Unit&) const {}
};

struct EpiBf16 {
    static constexpr bool PERM = true, AFTER_DRAIN = false;
    bf16_t* O; int ldc;
    __device__ __forceinline__ void operator()(const f32x4 (&acc)[2][2][4][2], const Unit& u, int wr, int wc, int fr, int fq) const {
        const int row0 = u.pm * BM + wr * 64 + fr; const int col0 = u.pn * BM + wc * 32 + 8 * fq;
#pragma unroll
        for (int ai = 0; ai < 2; ++ai)
#pragma unroll
            for (int m = 0; m < 4; ++m) { bf16_t* rowp = O + (size_t)(row0 + ai * HALF + m * 16) * ldc + col0;
#pragma unroll
                for (int bj = 0; bj < 2; ++bj) { const f32x4 v0 = acc[ai][bj][m][0], v1 = acc[ai][bj][m][1];
                    u32x4 w; w.x = cvt_pk_bf16(v0[0], v0[1]); w.y = cvt_pk_bf16(v0[2], v0[3]); w.z = cvt_pk_bf16(v1[0], v1[1]); w.w = cvt_pk_bf16(v1[2], v1[3]);
                    *(u32x4*)(rowp + bj * HALF) = w; } }
    }
};

struct EpiQKV {
    static constexpr bool PERM = true, AFTER_DRAIN = false;
    bf16_t* Q; bf16_t* KV; const float* qg; const float* kg; const f32x2* rope; PG8_LAS unsigned char* xch;
    __device__ __forceinline__ void operator()(const f32x4 (&acc)[2][2][4][2], const Unit& u, int wr, int wc, int fr_in, int fq_in) const {
        int fr = fr_in, fq = fq_in; asm volatile("" : "+v"(fr), "+v"(fq));
        const int pn = u.pn, pm = u.pm;
        const bool isctx = pm >= MTOK / 256, donorm = (pn < 2) || (pn == 4), dorope = !isctx && (pn < 5 || pn == 6);
        if (isctx && pn < 4) return;
        PG8_LAS float* P = (PG8_LAS float*)xch;
        if (donorm) {
#pragma unroll
            for (int ai = 0; ai < 2; ++ai)
#pragma unroll
                for (int m = 0; m < 4; ++m)
#pragma unroll
                    for (int bj = 0; bj < 2; ++bj) { const f32x4 v0 = acc[ai][bj][m][0], v1 = acc[ai][bj][m][1];
                        float ss = (v0[0] * v0[0] + v0[1] * v0[1]) + (v0[2] * v0[2] + v0[3] * v0[3]) + (v1[0] * v1[0] + v1[1] * v1[1]) + (v1[2] * v1[2] + v1[3] * v1[3]);
                        ss += __shfl_xor(ss, 16); ss += __shfl_xor(ss, 32);
                        if (fq == 0) P[((128 * ai + 64 * wr + 16 * m + fr) * 2 + bj) * 4 + wc] = ss; }
            asm volatile("s_waitcnt lgkmcnt(0)" ::: "memory"); __builtin_amdgcn_s_barrier(); asm volatile("" ::: "memory");
        }
        const int ax = wc >> 1, f0 = 16 * (wc & 1) + 4 * fq, dl = 64 * ax + f0;
        f32x4 g1 = {1.f, 1.f, 1.f, 1.f}, g2 = {1.f, 1.f, 1.f, 1.f};
        if (donorm) { const float* gp = (pn == 4) ? kg : qg; g1 = *(const f32x4*)(gp + dl); g2 = *(const f32x4*)(gp + dl + 32); }
        const int col0 = wc * 32 + 8 * fq;
#pragma unroll
        for (int ai = 0; ai < 2; ++ai)
#pragma unroll
            for (int m = 0; m < 4; ++m) {
                const int rl = 128 * ai + 64 * wr + 16 * m + fr, grow = 256 * pm + rl;
                const int b = isctx ? ((grow - MTOK) >> 8) : (grow >> 14), t = isctx ? ((grow - MTOK) & 255) : (grow & (SEQ - 1));
                f32x4 cA = {1.f, 0.f, 1.f, 0.f}, cB = {1.f, 0.f, 1.f, 0.f};
                if (dorope) { const int pos = ax ? (t & 63) : (t >> 6); const f32x4* rp = (const f32x4*)(rope + pos * 32 + f0); cA = rp[0]; cB = rp[1]; }
                const f32x4 cs = {cA[0], cA[2], cB[0], cB[2]}, sn = {cA[1], cA[3], cB[1], cB[3]};
#pragma unroll
                for (int bj = 0; bj < 2; ++bj) {
                    f32x4 x1 = acc[ai][bj][m][0], x2 = acc[ai][bj][m][1];
                    if (donorm) { const f32x4 pp = *(const PG8_LAS f32x4*)(P + (rl * 2 + bj) * 4); const float r = rsqrtf(((pp[0] + pp[1]) + (pp[2] + pp[3])) * (1.0f / 128.0f) + EPS);
                        x1 = x1 * r * g1; x2 = x2 * r * g2; }
                    const f32x4 o1 = x1 * cs - x2 * sn, o2 = x2 * cs + x1 * sn;
                    u32x4 w; w.x = cvt_pk_bf16(o1[0], o1[1]); w.y = cvt_pk_bf16(o1[2], o1[3]); w.z = cvt_pk_bf16(o2[0], o2[1]); w.w = cvt_pk_bf16(o2[2], o2[3]);
                    bf16_t* dst = (pn < 4) ? Q + (size_t)grow * DM + pn * 256 + bj * 128 + col0
                                           : KV + (size_t)(pn - 4) * (KV_BYTES / 2) + ((size_t)(b * 2 + bj) * SKV + (isctx ? t : CTXL + t)) * HD + col0;
                    *(u32x4*)dst = w;
                }
            }
    }
};

__device__ __forceinline__ float dpp_shr1(float old, float src) { return __builtin_bit_cast(float, __builtin_amdgcn_update_dpp(__builtin_bit_cast(int, old), __builtin_bit_cast(int, src), 0x111, 0xf, 0xf, false)); }
__device__ __forceinline__ float dpp_shl1(float old, float src) { return __builtin_bit_cast(float, __builtin_amdgcn_update_dpp(__builtin_bit_cast(int, old), __builtin_bit_cast(int, src), 0x101, 0xf, 0xf, false)); }
__device__ __forceinline__ float dpp_ror1(float src) { return __builtin_bit_cast(float, __builtin_amdgcn_update_dpp(0, __builtin_bit_cast(int, src), 0x121, 0xf, 0xf, false)); }
__device__ __forceinline__ float dpp_rol1(float src) { return __builtin_bit_cast(float, __builtin_amdgcn_update_dpp(0, __builtin_bit_cast(int, src), 0x12F, 0xf, 0xf, false)); }

struct EpiConvGate {
    static constexpr bool PERM = false, AFTER_DRAIN = false;
    bf16_t* ACT; const float* cw; const float* cb; PG8_LAS unsigned char* xch; bf16_t* EDGE;
    __device__ __forceinline__ void operator()(const f32x4 (&acc)[2][2][4][2], const Unit& u, int wr, int wc, int fr_in, int fq_in) const {
        int fr = fr_in, fq = fq_in; asm volatile("" : "+v"(fr), "+v"(fq));
        PG8_LAS f32x4* XF = (PG8_LAS f32x4*)xch; PG8_LAS f32x4* XL = XF + 256;
#pragma unroll
        for (int ai = 0; ai < 2; ++ai) { const int idx = (((2 * ai + wr) * 4 + wc) * 4 + fq) * 4;
            if (fr == 0) {
#pragma unroll
                for (int bj = 0; bj < 2; ++bj)
#pragma unroll
                    for (int n = 0; n < 2; ++n) XF[idx + bj * 2 + n] = acc[ai][bj][0][n]; }
            if (fr == 15) {
#pragma unroll
                for (int bj = 0; bj < 2; ++bj)
#pragma unroll
                    for (int n = 0; n < 2; ++n) XL[idx + bj * 2 + n] = acc[ai][bj][3][n]; } }
        asm volatile("s_waitcnt lgkmcnt(0)" ::: "memory"); __builtin_amdgcn_s_barrier(); asm volatile("" ::: "memory");
        const int jcol = u.pn * 128 + wc * 32 + 4 * fq;
#if CONV_ALIGNED
        if ((wr == 0 && fr < 2) || (wr == 1 && fr >= 14)) { const int slot = (wr == 0) ? fr : fr - 12;
#pragma unroll
            for (int bj = 0; bj < 2; ++bj)
#pragma unroll
                for (int n = 0; n < 2; ++n) { const f32x4 v = (wr == 0) ? acc[0][bj][0][n] : acc[1][bj][3][n]; u32x2 w; w.x = cvt_pk_bf16(v[0], v[1]); w.y = cvt_pk_bf16(v[2], v[3]);
                    *(u32x2*)(EDGE + ((size_t)u.pm * 4 + slot) * NUP + bj * DFF + jcol + 16 * n) = w; } }
#endif
        const int Tlo = 254 * u.pm - 1; const bool edge = ((Tlo + 1) & (SEQ - 1)) > ((Tlo + 256) & (SEQ - 1)) || ((Tlo + 1) & (SEQ - 1)) == 0;
#pragma unroll
        for (int n = 0; n < 2; ++n) {
            f32x4 w0[2], w1[2], w2[2], bb[2];
            __attribute__((address_space(1))) bf16_t* sp = (__attribute__((address_space(1))) bf16_t*)ACT + (long)((CONV_ALIGNED ? 256 * u.pm : 254 * u.pm - 1) + 64 * wr + fr) * DFF + jcol + 16 * n;
#pragma unroll
            for (int bj = 0; bj < 2; ++bj) { const int col = bj * DFF + jcol + 16 * n;
                w0[bj] = *(const f32x4*)(cw + col); w1[bj] = *(const f32x4*)(cw + NUP + col); w2[bj] = *(const f32x4*)(cw + 2 * NUP + col); bb[bj] = *(const f32x4*)(cb + col); }
#pragma unroll
            for (int ai = 0; ai < 2; ++ai) {
                const int G = 2 * ai + wr;
                f32x4 hp[2], hn[2];
#pragma unroll
                for (int bj = 0; bj < 2; ++bj) { hp[bj] = XL[((((G + 3) & 3) * 4 + wc) * 4 + fq) * 4 + bj * 2 + n]; hn[bj] = XF[((((G + 1) & 3) * 4 + wc) * 4 + fq) * 4 + bj * 2 + n]; }
#pragma unroll
                for (int m = 0; m < 4; ++m) {
                    const int rl = 128 * ai + 64 * wr + 16 * m + fr; const int T = (CONV_ALIGNED ? 256 * u.pm : 254 * u.pm - 1) + rl; const int tin = T & (SEQ - 1);
                    const bool first = (tin == 0), last = (tin == SEQ - 1), valid = (rl >= 1) && (rl <= 254) && (T < MTOK);
                    f32x4 uu[2];
#pragma unroll
                    for (int bj = 0; bj < 2; ++bj) {
                        const f32x4 cur = acc[ai][bj][m][n]; f32x4 prv, nxt;
#pragma unroll
                        for (int i = 0; i < 4; ++i) {
                            const float op = (m == 0) ? hp[bj][i] : dpp_ror1(acc[ai][bj][m == 0 ? 0 : m - 1][n][i]);
                            const float on = (m == 3) ? hn[bj][i] : dpp_rol1(acc[ai][bj][m == 3 ? 3 : m + 1][n][i]);
                            prv[i] = dpp_shr1(op, cur[i]); nxt[i] = dpp_shl1(on, cur[i]); }
                        if (!CONV_ALIGNED && edge) { if (first) prv = (f32x4){0.f, 0.f, 0.f, 0.f}; if (last) nxt = (f32x4){0.f, 0.f, 0.f, 0.f}; }
                        uu[bj] = w0[bj] * prv + w1[bj] * cur + w2[bj] * nxt + bb[bj];
                    }
                    float a[4];
#pragma unroll
                    for (int i = 0; i < 4; ++i) { const float gv = uu[0][i]; const float sg = __builtin_amdgcn_rcpf(1.0f + __builtin_amdgcn_exp2f(-1.4426950408889634f * gv)); a[i] = gv * sg * uu[1][i]; }
                    if (valid) { u32x2 w; w.x = cvt_pk_bf16(a[0], a[1]); w.y = cvt_pk_bf16(a[2], a[3]); *(__attribute__((address_space(1))) u32x2*)sp = w; }
                    sp += (m == 3 ? 80 : 16) * DFF; asm volatile("" : "+v"(sp));
                }
            }
        }
    }
};

template <class Epi, class Sched, bool ALIGN_EPI = false, bool SP2 = false>
__device__ __forceinline__ void gemm_phase(PG8_LAS unsigned char* lds, const Gemm g, const Sched& S, const Epi& E, int tid_in) {
    int tid_o = tid_in; asm volatile("" : "+v"(tid_o));
    const int tid = tid_o, wid = __builtin_amdgcn_readfirstlane(tid >> 6), lane = tid & 63, wr = wid >> 2, wc = wid & 3, fr = lane & 15, fq = lane >> 4;
    const int K = g.K, nt = K / BK;
    unsigned voffA[2], voffB[2];
#pragma unroll
    for (int i = 0; i < 2; ++i) { int R, C; stage_rc(tid * 16 + i * 8192, R, C); const int Rb = Epi::PERM ? ((R & ~31) + perm32(R & 31)) : R;
        voffA[i] = (unsigned)(R * K + C) * 2u; voffB[i] = (unsigned)(Rb * K + C) * 2u; }
    const size_t kstep = (size_t)(BK * 2);
    const size_t hstep = (size_t)HALF * K * 2;
    const size_t tstep = 2 * hstep; const size_t tstepA = (size_t)g.a_rows * K * 2;
    const unsigned ldsw = (unsigned)wid * 1024u;
    const int aoff = lds_byte(wr * 64 + fr, fq * 8), boff = lds_byte(wc * 32 + fr, fq * 8);
#define PG8_SA(b, h) (((b) * 2 + (h)) * HTB)
#define PG8_SB(b, h) ((4 + (b) * 2 + (h)) * HTB)
#define PG8_STAGE(bufoff, gbase, voff) do { _Pragma("unroll") for (int _i = 0; _i < 2; ++_i) \
        __builtin_amdgcn_global_load_lds((const unsigned*)((const char*)(gbase) + (voff)[_i]), (PG8_LAS unsigned*)(lds + (bufoff) + ldsw + _i * 8192), 16, 0, 0); } while (0)
#define PG8_LDA(dst, b, h) do { _Pragma("unroll") for (int m = 0; m < 4; ++m) _Pragma("unroll") for (int k = 0; k < 2; ++k) dst[m][k] = *(const PG8_LAS bf16x8*)(lds + PG8_SA(b, h) + aoff + m * 2048 + k * 1024); } while (0)
#define PG8_LDB(dst, b, h) do { _Pragma("unroll") for (int n = 0; n < 2; ++n) _Pragma("unroll") for (int k = 0; k < 2; ++k) dst[n][k] = *(const PG8_LAS bf16x8*)(lds + PG8_SB(b, h) + boff + n * 2048 + k * 1024); } while (0)
#define PG8_MMA(ai, bj, At, Bt) do { __builtin_amdgcn_s_setprio(1); _Pragma("unroll") for (int m = 0; m < 4; ++m) _Pragma("unroll") for (int n = 0; n < 2; ++n) _Pragma("unroll") for (int k = 0; k < 2; ++k) \
        acc[ai][bj][m][n] = __builtin_amdgcn_mfma_f32_16x16x32_bf16(Bt[n][k], At[m][k], acc[ai][bj][m][n], 0, 0, 0); __builtin_amdgcn_s_setprio(0); } while (0)
#define PG8_WAIT_V(n) asm volatile("s_waitcnt vmcnt(" #n ")" ::: "memory")
#define PG8_WAIT_L(n) asm volatile("s_waitcnt lgkmcnt(" #n ")" ::: "memory")
#define PG8_BAR __builtin_amdgcn_s_barrier()
#define PG8_SCHED __builtin_amdgcn_sched_barrier(0)
    Unit cur, nxt; int ui = 0;
    if (!S.next(0, cur)) return;
    f32x4 acc[2][2][4][2];
#pragma unroll
    for (int a = 0; a < 2; ++a)
#pragma unroll
        for (int b = 0; b < 2; ++b)
#pragma unroll
            for (int m = 0; m < 4; ++m)
#pragma unroll
                for (int n = 0; n < 2; ++n) acc[a][b][m][n] = (f32x4){0.f, 0.f, 0.f, 0.f};
    bf16x8 At[4][2], B0[2][2], B1[2][2];
    const char* cA = (const char*)g.A + (size_t)cur.pm * tstepA; const char* cB = (const char*)g.Bt + (size_t)cur.pn * tstep + (cur.pm >= g.msplit ? g.bsplit : (size_t)0);
    S.a_ready(cur);
    if constexpr (SP2) {
        PG8_STAGE(PG8_SB(0, 0), cB, voffB); PG8_STAGE(PG8_SB(0, 1), cB + hstep, voffB); PG8_STAGE(PG8_SA(0, 0), cA, voffA); PG8_STAGE(PG8_SA(0, 1), cA + hstep, voffA);
        if (wr == 1) PG8_BAR;
        PG8_WAIT_V(2); PG8_BAR;
        PG8_STAGE(PG8_SB(1, 0), cB + kstep, voffB); PG8_STAGE(PG8_SA(1, 0), cA + kstep, voffA); PG8_STAGE(PG8_SB(1, 1), cB + hstep + kstep, voffB);
        PG8_WAIT_V(6); PG8_BAR;
    } else {
        PG8_STAGE(PG8_SB(0, 0), cB, voffB); PG8_STAGE(PG8_SA(0, 0), cA, voffA); PG8_STAGE(PG8_SB(0, 1), cB + hstep, voffB); PG8_STAGE(PG8_SA(0, 1), cA + hstep, voffA);
        if (wr == 1) PG8_BAR;
        PG8_WAIT_V(4); PG8_BAR;
        PG8_STAGE(PG8_SB(1, 0), cB + kstep, voffB); PG8_STAGE(PG8_SA(1, 0), cA + kstep, voffA); PG8_STAGE(PG8_SB(1, 1), cB + hstep + kstep, voffB);
        PG8_WAIT_V(6); PG8_BAR;
    }
    for (;;) {
        const bool has_next = S.next(ui + 1, nxt);
        const char* nA = has_next ? (const char*)g.A + (size_t)nxt.pm * tstepA : cA; const char* nB = has_next ? (const char*)g.Bt + (size_t)nxt.pn * tstep + (nxt.pm >= g.msplit ? g.bsplit : (size_t)0) : cB;
        for (int t = 0; t < nt; t += 2) {
            const bool last = (t == nt - 2);
            const char* a1 = cA + (size_t)(t + 1) * kstep;
            const char* a2 = last ? nA : cA + (size_t)(t + 2) * kstep; const char* b2 = last ? nB : cB + (size_t)(t + 2) * kstep;
            const char* a3 = a2 + kstep; const char* b3 = b2 + kstep;
            if (last && has_next) S.a_ready(nxt);
            if constexpr (SP2) {
            PG8_LDB(B0, 0, 0); PG8_LDB(B1, 0, 1); PG8_SCHED; PG8_LDA(At, 0, 0); PG8_STAGE(PG8_SA(1, 1), a1 + hstep, voffA);
            PG8_WAIT_V(8); PG8_WAIT_L(0); PG8_BAR; PG8_MMA(0, 0, At, B0); PG8_MMA(0, 1, At, B1); PG8_BAR; PG8_SCHED;
            PG8_LDA(At, 0, 1); PG8_STAGE(PG8_SB(0, 0), b2, voffB); PG8_STAGE(PG8_SB(0, 1), b2 + hstep, voffB); PG8_STAGE(PG8_SA(0, 0), a2, voffA);
            PG8_WAIT_V(8); PG8_WAIT_L(0); PG8_BAR; PG8_MMA(1, 0, At, B0); PG8_MMA(1, 1, At, B1); PG8_BAR; PG8_SCHED;
            PG8_LDB(B0, 1, 0); PG8_LDB(B1, 1, 1); PG8_SCHED; PG8_LDA(At, 1, 0); PG8_STAGE(PG8_SA(0, 1), a2 + hstep, voffA);
            PG8_WAIT_V(8); PG8_WAIT_L(0); PG8_BAR; PG8_MMA(0, 0, At, B0); PG8_MMA(0, 1, At, B1); PG8_BAR; PG8_SCHED;
            PG8_LDA(At, 1, 1); PG8_STAGE(PG8_SB(1, 0), b3, voffB); PG8_STAGE(PG8_SB(1, 1), b3 + hstep, voffB); PG8_STAGE(PG8_SA(1, 0), a3, voffA);
            PG8_WAIT_V(8); PG8_WAIT_L(0); PG8_BAR; PG8_MMA(1, 0, At, B0); PG8_MMA(1, 1, At, B1); PG8_BAR; PG8_SCHED;
            } else {
            PG8_LDB(B0, 0, 0); PG8_SCHED; PG8_LDA(At, 0, 0); PG8_STAGE(PG8_SA(1, 1), a1 + hstep, voffA);
            PG8_WAIT_L(8); PG8_BAR; PG8_WAIT_L(0); PG8_MMA(0, 0, At, B0); PG8_BAR; PG8_SCHED;
            PG8_LDB(B1, 0, 1); PG8_STAGE(PG8_SB(0, 0), b2, voffB);
            PG8_BAR; PG8_WAIT_L(0); PG8_MMA(0, 1, At, B1); PG8_BAR;
            PG8_LDA(At, 0, 1); PG8_STAGE(PG8_SA(0, 0), a2, voffA);
            PG8_BAR; PG8_WAIT_L(0); PG8_MMA(1, 0, At, B0); PG8_BAR; PG8_SCHED;
            PG8_STAGE(PG8_SB(0, 1), b2 + hstep, voffB);
            PG8_WAIT_V(6); PG8_BAR; PG8_MMA(1, 1, At, B1); PG8_BAR;
            PG8_LDB(B0, 1, 0); PG8_SCHED; PG8_LDA(At, 1, 0); PG8_STAGE(PG8_SA(0, 1), a2 + hstep, voffA);
            PG8_WAIT_L(8); PG8_BAR; PG8_WAIT_L(0); PG8_MMA(0, 0, At, B0); PG8_BAR; PG8_SCHED;
            PG8_LDB(B1, 1, 1); PG8_STAGE(PG8_SB(1, 0), b3, voffB);
            PG8_BAR; PG8_WAIT_L(0); PG8_MMA(0, 1, At, B1); PG8_BAR;
            PG8_LDA(At, 1, 1); PG8_STAGE(PG8_SA(1, 0), a3, voffA);
            PG8_BAR; PG8_WAIT_L(0); PG8_MMA(1, 0, At, B0); PG8_BAR; PG8_SCHED;
            PG8_STAGE(PG8_SB(1, 1), b3 + hstep, voffB);
            PG8_WAIT_V(6); PG8_BAR; PG8_MMA(1, 1, At, B1); PG8_BAR;
            }
        }
        if constexpr (ALIGN_EPI) { if (wr == 0) PG8_BAR; }
        if constexpr (!Epi::AFTER_DRAIN) { E(acc, cur, wr, wc, fr, fq); S.done(cur); }
        if (!has_next) break;
#pragma unroll
        for (int a = 0; a < 2; ++a)
#pragma unroll
            for (int b = 0; b < 2; ++b)
#pragma unroll
                for (int m = 0; m < 4; ++m)
#pragma unroll
                    for (int n = 0; n < 2; ++n) acc[a][b][m][n] = (f32x4){0.f, 0.f, 0.f, 0.f};
        cur = nxt; cA = nA; cB = nB; ++ui;
        if constexpr (ALIGN_EPI) { if (wr == 1) PG8_BAR; }
    }
    PG8_WAIT_V(0);
    if constexpr (!ALIGN_EPI) { if (wr == 0) PG8_BAR; }
    PG8_BAR;
    if constexpr (Epi::AFTER_DRAIN) { E.fused(acc, cur, wr, wc, fr, fq, lds, wid, lane); S.done(cur); }
#undef PG8_SA
#undef PG8_SB
#undef PG8_STAGE
#undef PG8_LDA
#undef PG8_LDB
#undef PG8_MMA
#undef PG8_WAIT_V
#undef PG8_WAIT_L
#undef PG8_BAR
#undef PG8_SCHED
}
}
namespace att {
constexpr int D = 128, NW = 8, QBLK = 32, KVBLK = 64;
constexpr float SCALE = 0.088388347648318440f;
constexpr float THR = 8.f;
#ifndef ATT_SDEPTH
#define ATT_SDEPTH 2
#endif
#ifndef ATT_SDEPTH_FIX
#define ATT_SDEPTH_FIX 1
#endif
#ifndef ATT_FIXQLDS
#define ATT_FIXQLDS 0
#endif
#ifndef ATT_PVILP
#define ATT_PVILP 0
#endif
#ifndef ATT_PVPIPE
#define ATT_PVPIPE 0
#endif
#ifndef ATT_RING3
#define ATT_RING3 0
#endif
constexpr int SDEPTH = ATT_SDEPTH;
constexpr int LDQ = 1024, LDK = 128;
constexpr size_t SHM_V = KVBLK * D * 2, SHM_K = KVBLK * D * 2, SHM_ATTN = 2 * SHM_V + 2 * SHM_K + NW * 64 * 4;
#define KSWZ(row, colB) ((row) * 256 + ((colB) ^ (((row) & 7) << 4)))
#define SBAR() __builtin_amdgcn_sched_barrier(0)
__device__ __forceinline__ int crow(int r, int hi) { return (r & 3) + 8 * (r >> 2) + 4 * hi; }
template <bool MASK, bool FIX = false>
__device__ __forceinline__ void partialSM(f32x16& p0, f32x16& p1, float& m_reg, float& mn, float& alpha, int dm, int hi) {
  constexpr float C = SCALE * 1.4426950408889634f;
  if (MASK) {
#pragma unroll
    for (int r = 0; r < 16; ++r) { const int k0 = dm + crow(r, hi); if (k0 > 128 || k0 < -128) p0[r] = -1e30f; if (k0 + 32 > 128 || k0 + 32 < -128) p1[r] = -1e30f; }
  }
  if (FIX) {
    mn = m_reg; alpha = 1.f;
#pragma unroll
    for (int r = 0; r < 16; ++r) p0[r] = __builtin_amdgcn_exp2f(p0[r]);
    return;
  }
  {
  float pmax = p0[0];
#pragma unroll
  for (int r = 1; r < 16; ++r) pmax = fmaxf(pmax, p0[r]);
#pragma unroll
  for (int r = 0; r < 16; ++r) pmax = fmaxf(pmax, p1[r]);
  { auto rr = __builtin_amdgcn_permlane32_swap(__float_as_uint(pmax), __float_as_uint(pmax), false, false);
    pmax = fmaxf(__uint_as_float(rr[0]), __uint_as_float(rr[1])); }
  if (__builtin_expect(__all(pmax - m_reg <= THR / SCALE), 1)) { mn = m_reg; alpha = 1.f; }
  else { mn = fmaxf(m_reg, pmax); alpha = __builtin_amdgcn_exp2f((m_reg - mn) * C); m_reg = mn; }
  }
  float mnC = -mn * C;
#pragma unroll
  for (int r = 0; r < 16; ++r) p0[r] = fmaf(p0[r], C, mnC);
#pragma unroll
  for (int r = 0; r < 16; ++r) p1[r] = fmaf(p1[r], C, mnC);
#pragma unroll
  for (int r = 0; r < 16; ++r) p0[r] = __builtin_amdgcn_exp2f(p0[r]);
}
template <bool FIX = false>
__device__ __forceinline__ void finishSM(f32x16& p0, f32x16& p1, float alpha, float& l_reg, bf16x8& pa0, bf16x8& pa1, bf16x8& pa2, bf16x8& pa3) {
#pragma unroll
  for (int r = 0; r < 16; ++r) p1[r] = __builtin_amdgcn_exp2f(p1[r]);
  float ps = 0;
#pragma unroll
  for (int r = 0; r < 16; ++r) ps += p0[r];
#pragma unroll
  for (int r = 0; r < 16; ++r) ps += p1[r];
  if (FIX) {
    l_reg += ps;
#define PK8(P, BASE, OUT) do { u32x4 w = {cvt_pk_bf16(P[BASE + 0], P[BASE + 1]), cvt_pk_bf16(P[BASE + 2], P[BASE + 3]), cvt_pk_bf16(P[BASE + 4], P[BASE + 5]), cvt_pk_bf16(P[BASE + 6], P[BASE + 7])}; OUT = *reinterpret_cast<bf16x8*>(&w); } while (0)
    PK8(p0, 0, pa0); PK8(p0, 8, pa1); PK8(p1, 0, pa2); PK8(p1, 8, pa3);
#undef PK8
    return;
  }
  { auto rr = __builtin_amdgcn_permlane32_swap(__float_as_uint(ps), __float_as_uint(ps), false, false);
    ps = __uint_as_float(rr[0]) + __uint_as_float(rr[1]); }
  l_reg = l_reg * alpha + ps;
#define PK4(P, BASE, OUT) do { unsigned a0 = cvt_pk_bf16(P[BASE + 0], P[BASE + 1]), a1 = cvt_pk_bf16(P[BASE + 2], P[BASE + 3]);   \
    unsigned b0 = cvt_pk_bf16(P[BASE + 4], P[BASE + 5]), b1 = cvt_pk_bf16(P[BASE + 6], P[BASE + 7]);                              \
    auto r0 = __builtin_amdgcn_permlane32_swap(a0, b0, false, false); auto r1 = __builtin_amdgcn_permlane32_swap(a1, b1, false, false); \
    u32x4 w = {r0[0], r1[0], r0[1], r1[1]}; OUT = *reinterpret_cast<bf16x8*>(&w); } while (0)
  PK4(p0, 0, pa0); PK4(p0, 8, pa1); PK4(p1, 0, pa2); PK4(p1, 8, pa3);
#undef PK4
}
template <bool QLDS, bool FIX = false>
__device__ __forceinline__ void qkt(f32x16& p0, f32x16& p1, const bf16_t* Ks, const bf16x8* qr, unsigned qaddr, int r32, int hi, const f32x16& negm) {
  if (FIX) { p0 = negm; p1 = negm; } else { p0 = f32x16{}; p1 = f32x16{}; }
  if (QLDS) asm volatile("" : "+v"(qaddr));
  const LAS bf16x8* ql = (const LAS bf16x8*)(uintptr_t)qaddr;
#pragma unroll
  for (int d0 = 0; d0 < 8; ++d0) { int cb = (d0 * 16 + hi * 8) * 2; const bf16x8 qf = QLDS ? ql[d0 * 64] : qr[d0];
    bf16x8 b0 = *reinterpret_cast<const bf16x8*>((const char*)Ks + KSWZ(r32, cb));
    bf16x8 b1 = *reinterpret_cast<const bf16x8*>((const char*)Ks + KSWZ(32 + r32, cb));
    p0 = __builtin_amdgcn_mfma_f32_32x32x16_bf16(b0, qf, p0, 0, 0, 0);
    p1 = __builtin_amdgcn_mfma_f32_32x32x16_bf16(b1, qf, p1, 0, 0, 0); }
}
__device__ __forceinline__ int v_st(int k, int c) { const int kk = (k & ~0xC) | ((k & 4) << 1) | ((k & 8) >> 1); return ((kk >> 3) * 4 + (c >> 5)) * 512 + ((kk & 7) * 32 + (c & 31)) * 2; }
__device__ __forceinline__ int v_rd_base(int lane) { return ((lane & 3) << 3) | (((lane >> 2) & 3) << 6) | (((lane >> 4) & 1) << 5) | (((lane >> 5) & 1) << 8); }
constexpr int v_rd_off(int d0, int ks, int half) { return d0 * 512 + ks * 4096 + half * 2048; }
template <int OFF> __device__ __forceinline__ s16x4 tr_read(int vb) {
  s16x4 r; asm volatile("ds_read_b64_tr_b16 %0, %1 offset:%2" : "=&v"(r) : "v"(vb), "i"(OFF) : "memory"); return r;
}
#define PKLH(L, H) (bf16x8){L[0], L[1], L[2], L[3], H[0], H[1], H[2], H[3]}
template <int D0> __device__ __forceinline__ void pv_one(f32x16& od, int vb, bf16x8 pa0, bf16x8 pa1, bf16x8 pa2, bf16x8 pa3) {
  const s16x4 l0 = tr_read<v_rd_off(D0, 0, 0)>(vb), h0 = tr_read<v_rd_off(D0, 0, 1)>(vb), l1 = tr_read<v_rd_off(D0, 1, 0)>(vb), h1 = tr_read<v_rd_off(D0, 1, 1)>(vb);
  const s16x4 l2 = tr_read<v_rd_off(D0, 2, 0)>(vb), h2 = tr_read<v_rd_off(D0, 2, 1)>(vb), l3 = tr_read<v_rd_off(D0, 3, 0)>(vb), h3 = tr_read<v_rd_off(D0, 3, 1)>(vb);
  asm volatile("s_waitcnt lgkmcnt(0)" ::: "memory"); SBAR();
  od = __builtin_amdgcn_mfma_f32_32x32x16_bf16(pa0, PKLH(l0, h0), od, 0, 0, 0);
  od = __builtin_amdgcn_mfma_f32_32x32x16_bf16(pa1, PKLH(l1, h1), od, 0, 0, 0);
  od = __builtin_amdgcn_mfma_f32_32x32x16_bf16(pa2, PKLH(l2, h2), od, 0, 0, 0);
  od = __builtin_amdgcn_mfma_f32_32x32x16_bf16(pa3, PKLH(l3, h3), od, 0, 0, 0);
}
#define PV_RD(D0, L0, H0, L1, H1, L2, H2, L3, H3) do { L0 = tr_read<v_rd_off(D0, 0, 0)>(vb); H0 = tr_read<v_rd_off(D0, 0, 1)>(vb); L1 = tr_read<v_rd_off(D0, 1, 0)>(vb); H1 = tr_read<v_rd_off(D0, 1, 1)>(vb); \
    L2 = tr_read<v_rd_off(D0, 2, 0)>(vb); H2 = tr_read<v_rd_off(D0, 2, 1)>(vb); L3 = tr_read<v_rd_off(D0, 3, 0)>(vb); H3 = tr_read<v_rd_off(D0, 3, 1)>(vb); } while (0)
#define PV_MM(OD, L0, H0, L1, H1, L2, H2, L3, H3) do { OD = __builtin_amdgcn_mfma_f32_32x32x16_bf16(pa0, PKLH(L0, H0), OD, 0, 0, 0); OD = __builtin_amdgcn_mfma_f32_32x32x16_bf16(pa1, PKLH(L1, H1), OD, 0, 0, 0); \
    OD = __builtin_amdgcn_mfma_f32_32x32x16_bf16(pa2, PKLH(L2, H2), OD, 0, 0, 0); OD = __builtin_amdgcn_mfma_f32_32x32x16_bf16(pa3, PKLH(L3, H3), OD, 0, 0, 0); } while (0)
template <bool ILP = false>
__device__ __forceinline__ void pv_d0(f32x16* o, int vb, bf16x8 pa0, bf16x8 pa1, bf16x8 pa2, bf16x8 pa3) {
#if ATT_PVPIPE
  s16x4 al0, ah0, al1, ah1, al2, ah2, al3, ah3, bl0, bh0, bl1, bh1, bl2, bh2, bl3, bh3;
  PV_RD(0, al0, ah0, al1, ah1, al2, ah2, al3, ah3); PV_RD(1, bl0, bh0, bl1, bh1, bl2, bh2, bl3, bh3);
  asm volatile("s_waitcnt lgkmcnt(8)" ::: "memory"); SBAR(); PV_MM(o[0], al0, ah0, al1, ah1, al2, ah2, al3, ah3); SBAR();
  PV_RD(2, al0, ah0, al1, ah1, al2, ah2, al3, ah3);
  asm volatile("s_waitcnt lgkmcnt(8)" ::: "memory"); SBAR(); PV_MM(o[1], bl0, bh0, bl1, bh1, bl2, bh2, bl3, bh3); SBAR();
  PV_RD(3, bl0, bh0, bl1, bh1, bl2, bh2, bl3, bh3);
  asm volatile("s_waitcnt lgkmcnt(8)" ::: "memory"); SBAR(); PV_MM(o[2], al0, ah0, al1, ah1, al2, ah2, al3, ah3); SBAR();
  asm volatile("s_waitcnt lgkmcnt(0)" ::: "memory"); SBAR(); PV_MM(o[3], bl0, bh0, bl1, bh1, bl2, bh2, bl3, bh3);
#elif ATT_PVILP
  if constexpr (ILP)
  { s16x4 al0, ah0, al1, ah1, al2, ah2, al3, ah3, bl0, bh0, bl1, bh1, bl2, bh2, bl3, bh3;
#define PV_ILP(DA, DB) do { PV_RD(DA, al0, ah0, al1, ah1, al2, ah2, al3, ah3); PV_RD(DB, bl0, bh0, bl1, bh1, bl2, bh2, bl3, bh3); \
    asm volatile("s_waitcnt lgkmcnt(0)" ::: "memory"); SBAR(); \
    o[DA] = __builtin_amdgcn_mfma_f32_32x32x16_bf16(pa0, PKLH(al0, ah0), o[DA], 0, 0, 0); o[DB] = __builtin_amdgcn_mfma_f32_32x32x16_bf16(pa0, PKLH(bl0, bh0), o[DB], 0, 0, 0); \
    o[DA] = __builtin_amdgcn_mfma_f32_32x32x16_bf16(pa1, PKLH(al1, ah1), o[DA], 0, 0, 0); o[DB] = __builtin_amdgcn_mfma_f32_32x32x16_bf16(pa1, PKLH(bl1, bh1), o[DB], 0, 0, 0); \
    o[DA] = __builtin_amdgcn_mfma_f32_32x32x16_bf16(pa2, PKLH(al2, ah2), o[DA], 0, 0, 0); o[DB] = __builtin_amdgcn_mfma_f32_32x32x16_bf16(pa2, PKLH(bl2, bh2), o[DB], 0, 0, 0); \
    o[DA] = __builtin_amdgcn_mfma_f32_32x32x16_bf16(pa3, PKLH(al3, ah3), o[DA], 0, 0, 0); o[DB] = __builtin_amdgcn_mfma_f32_32x32x16_bf16(pa3, PKLH(bl3, bh3), o[DB], 0, 0, 0); SBAR(); } while (0)
    PV_ILP(0, 1); PV_ILP(2, 3);
#undef PV_ILP
  } else {
  pv_one<0>(o[0], vb, pa0, pa1, pa2, pa3); pv_one<1>(o[1], vb, pa0, pa1, pa2, pa3); pv_one<2>(o[2], vb, pa0, pa1, pa2, pa3); pv_one<3>(o[3], vb, pa0, pa1, pa2, pa3); }
#else
  pv_one<0>(o[0], vb, pa0, pa1, pa2, pa3); pv_one<1>(o[1], vb, pa0, pa1, pa2, pa3); pv_one<2>(o[2], vb, pa0, pa1, pa2, pa3); pv_one<3>(o[3], vb, pa0, pa1, pa2, pa3);
#endif
}

template <bool WIN, bool FIX = false>
__device__ __forceinline__ void attn_unit(const bf16_t* Qb, const bf16_t* __restrict__ Kh, const bf16_t* __restrict__ Vh, bf16_t* Ob, int NT, int lo_key, int dbase, float m_init, float l_init, char* lds, int tid_in) {
  int tid_o = tid_in; asm volatile("" : "+v"(tid_o));
  const int tid = tid_o, wid = tid >> 6, lane = tid & 63, r32 = lane & 31, hi = lane >> 5;
  constexpr int SD = FIX ? ATT_SDEPTH_FIX : att::SDEPTH;
  constexpr bool RING = (!WIN) && (ATT_RING3 != 0); constexpr int NBUF = RING ? 3 : 2;
  bf16_t* V_lds = (bf16_t*)lds; bf16_t* K_lds = (bf16_t*)(lds + NBUF * SHM_V);
  float* ws = (float*)(lds + NBUF * SHM_V + NBUF * SHM_K) + wid * 64; float* li_l = ws; float* al_l = ws + 32;
  float m_reg = m_init, l_reg = l_init; f32x16 o[4] = {}; bf16x8 qr[8];
  const unsigned qaddr = (unsigned)(uintptr_t)lds + 69632u + (unsigned)wid * 8192u + (unsigned)lane * 16u;
  const bf16_t* Qw = Qb + (long)(wid * QBLK + r32) * LDQ + hi * 8;
#pragma unroll
  for (int d0 = 0; d0 < 8; ++d0) qr[d0] = *reinterpret_cast<const bf16x8*>(Qw + d0 * 16);
  f32x16 negm = {};
  if constexpr (FIX) {
    constexpr float CQ = SCALE * 1.4426950408889634f;
#pragma unroll
    for (int d0 = 0; d0 < 8; ++d0) { u32x4 w = *reinterpret_cast<u32x4*>(&qr[d0]);
      w.x = cvt_pk_bf16(bf_lo(w.x) * CQ, bf_hi(w.x) * CQ); w.y = cvt_pk_bf16(bf_lo(w.y) * CQ, bf_hi(w.y) * CQ); w.z = cvt_pk_bf16(bf_lo(w.z) * CQ, bf_hi(w.z) * CQ); w.w = cvt_pk_bf16(bf_lo(w.w) * CQ, bf_hi(w.w) * CQ);
      qr[d0] = *reinterpret_cast<bf16x8*>(&w); }
    const float nb = -m_init * 1.4426950408889634f;
#pragma unroll
    for (int r = 0; r < 16; ++r) negm[r] = nb;
    asm volatile("" : "+v"(negm));
  }
  constexpr bool QL = WIN || (FIX && ATT_FIXQLDS);
  if constexpr (QL) {
#pragma unroll
    for (int d0 = 0; d0 < 8; ++d0) ((LAS bf16x8*)(uintptr_t)qaddr)[d0 * 64] = qr[d0];
  }
  const int sr = tid >> 4, sc = (tid & 15) * 8, vst0 = v_st(sr, sc), vst1 = v_st(32 + sr, sc);
  const int vb0 = (int)(uintptr_t)V_lds + v_rd_base(lane);
  const int srk = FIX ? ((sr & ~0xC) | ((sr & 4) << 1) | ((sr & 8) >> 1)) : sr;
  struct { bf16x8 vs0, vs1, ks0, ks1; } sr_[SD];
  const int dmw = dbase - wid * QBLK - r32;
#define KROW(j) (WIN ? ((j) < 4 ? (j) * KVBLK : lo_key + ((j) - 4) * KVBLK) : (j) * KVBLK)
#define DMJ(j) (dmw + ((j) - 4) * KVBLK)
#define SLOAD(i, k0) do { sr_[i].vs0 = *reinterpret_cast<const bf16x8*>(&Vh[(long)((k0) + sr) * LDK + sc]); sr_[i].vs1 = *reinterpret_cast<const bf16x8*>(&Vh[(long)((k0) + 32 + sr) * LDK + sc]); \
    sr_[i].ks0 = *reinterpret_cast<const bf16x8*>(&Kh[(long)((k0) + sr) * LDK + sc]); sr_[i].ks1 = *reinterpret_cast<const bf16x8*>(&Kh[(long)((k0) + 32 + sr) * LDK + sc]); } while (0)
#define SWRITE(b, i) do { *(bf16x8*)((char*)V_lds + (b) * SHM_V + vst0) = sr_[i].vs0;          \
    *(bf16x8*)((char*)V_lds + (b) * SHM_V + vst1) = sr_[i].vs1; int kc = sc * 2;               \
    *(bf16x8*)((char*)K_lds + (b) * SHM_K + KSWZ(srk, kc)) = sr_[i].ks0;                       \
    *(bf16x8*)((char*)K_lds + (b) * SHM_K + KSWZ(32 + srk, kc)) = sr_[i].ks1; } while (0)
#define SWAIT() do { if (SD == 2) asm volatile("s_waitcnt vmcnt(4)" ::: "memory"); else asm volatile("s_waitcnt vmcnt(0)" ::: "memory"); } while (0)
#define RESC(a) do { if (!FIX && __any((a) < 1.f)) { if (hi == 0) al_l[r32] = (a); asm volatile("s_waitcnt lgkmcnt(0)" ::: "memory"); \
    _Pragma("unroll") for (int d = 0; d < 4; ++d) _Pragma("unroll") for (int r = 0; r < 16; ++r) o[d][r] *= al_l[crow(r, hi)]; } } while (0)
  f32x16 pA0, pA1, pB0, pB1; float mnA, mnB, alA, alB; bf16x8 pa0, pa1, pa2, pa3;
  constexpr int SE = 0, SO = SD - 1;
  if constexpr (RING) {
#define RWRITE(off) do { *(bf16x8*)((char*)V_lds + (off) + vst0) = sr_[0].vs0; *(bf16x8*)((char*)V_lds + (off) + vst1) = sr_[0].vs1; const int kc_ = sc * 2; \
    *(bf16x8*)((char*)K_lds + (off) + KSWZ(srk, kc_)) = sr_[0].ks0; *(bf16x8*)((char*)K_lds + (off) + KSWZ(32 + srk, kc_)) = sr_[0].ks1; } while (0)
#define ROT3() do { const int t_ = o_prev; o_prev = o_cur; o_cur = o_next; o_next = t_; } while (0)
    int o_prev = 0, o_cur = (int)SHM_V, o_next = 2 * (int)SHM_V;
    SLOAD(0, KROW(0)); asm volatile("s_waitcnt vmcnt(0)" ::: "memory"); RWRITE(0); __syncthreads();
    qkt<QL, FIX>(pA0, pA1, K_lds, qr, qaddr, r32, hi, negm); partialSM<false, FIX>(pA0, pA1, m_reg, mnA, alA, 0, hi);
    SLOAD(0, KROW(1)); asm volatile("s_waitcnt vmcnt(0)" ::: "memory"); RWRITE(o_cur);
    if (2 < NT) SLOAD(0, KROW(2));
    __syncthreads();
    for (int j = 1; j + 1 < NT; j += 2) {
      asm volatile("s_waitcnt vmcnt(0)" ::: "memory"); RWRITE(o_next);
      SBAR(); qkt<QL, FIX>(pB0, pB1, (bf16_t*)((char*)K_lds + o_cur), qr, qaddr, r32, hi, negm);
      finishSM<FIX>(pA0, pA1, alA, l_reg, pa0, pa1, pa2, pa3); SBAR();
      if (j + 2 < NT) SLOAD(0, KROW(j + 2)); SBAR();
      pv_d0<FIX>(o, vb0 + o_prev, pa0, pa1, pa2, pa3);
      partialSM<false, FIX>(pB0, pB1, m_reg, mnB, alB, 0, hi);
      RESC(alB); __syncthreads(); ROT3();
      if (j + 2 < NT) { asm volatile("s_waitcnt vmcnt(0)" ::: "memory"); RWRITE(o_next); }
      SBAR(); qkt<QL, FIX>(pA0, pA1, (bf16_t*)((char*)K_lds + o_cur), qr, qaddr, r32, hi, negm);
      finishSM<FIX>(pB0, pB1, alB, l_reg, pa0, pa1, pa2, pa3); SBAR();
      if (j + 3 < NT) SLOAD(0, KROW(j + 3)); SBAR();
      pv_d0<FIX>(o, vb0 + o_prev, pa0, pa1, pa2, pa3);
      partialSM<false, FIX>(pA0, pA1, m_reg, mnA, alA, 0, hi);
      RESC(alA); __syncthreads(); ROT3();
    }
    SBAR(); qkt<QL, FIX>(pB0, pB1, (bf16_t*)((char*)K_lds + o_cur), qr, qaddr, r32, hi, negm);
    finishSM<FIX>(pA0, pA1, alA, l_reg, pa0, pa1, pa2, pa3); SBAR();
    pv_d0<FIX>(o, vb0 + o_prev, pa0, pa1, pa2, pa3);
    partialSM<false, FIX>(pB0, pB1, m_reg, mnB, alB, 0, hi);
    RESC(alB);
    finishSM<FIX>(pB0, pB1, alB, l_reg, pa0, pa1, pa2, pa3); SBAR();
    pv_d0<FIX>(o, vb0 + o_cur, pa0, pa1, pa2, pa3);
#undef RWRITE
#undef ROT3
  } else {
  SLOAD(SE, KROW(0)); asm volatile("s_waitcnt vmcnt(0)" ::: "memory"); SWRITE(0, SE); __syncthreads();
  qkt<QL, FIX>(pA0, pA1, K_lds, qr, qaddr, r32, hi, negm); partialSM<false, FIX>(pA0, pA1, m_reg, mnA, alA, 0, hi);
  SLOAD(SO, KROW(1)); if (SD == 2) { if (2 < NT) SLOAD(SE, KROW(2)); }
  SWAIT(); SWRITE(1, SO); __syncthreads();
  for (int j = 1; j + 1 < NT; j += 2) {
    SBAR(); qkt<QL, FIX>(pB0, pB1, (bf16_t*)((char*)K_lds + SHM_K), qr, qaddr, r32, hi, negm);
    finishSM<FIX>(pA0, pA1, alA, l_reg, pa0, pa1, pa2, pa3); SBAR();
    SLOAD(SO, KROW(j + SD)); SBAR();
    pv_d0<FIX>(o, vb0, pa0, pa1, pa2, pa3);
    if (WIN && j >= 4) partialSM<true>(pB0, pB1, m_reg, mnB, alB, DMJ(j), hi); else partialSM<false, FIX>(pB0, pB1, m_reg, mnB, alB, 0, hi);
    __syncthreads(); SWAIT(); SWRITE(0, SE);
    RESC(alB); __syncthreads();
    SBAR(); qkt<QL, FIX>(pA0, pA1, K_lds, qr, qaddr, r32, hi, negm);
    finishSM<FIX>(pB0, pB1, alB, l_reg, pa0, pa1, pa2, pa3); SBAR();
    if (SD == 1 || j + 3 < NT) SLOAD(SE, KROW(j + 1 + SD)); SBAR();
    pv_d0<FIX>(o, vb0 + (int)SHM_V, pa0, pa1, pa2, pa3);
    if (WIN && j + 1 >= 4) partialSM<true>(pA0, pA1, m_reg, mnA, alA, DMJ(j + 1), hi); else partialSM<false, FIX>(pA0, pA1, m_reg, mnA, alA, 0, hi);
    __syncthreads(); SWAIT(); SWRITE(1, SO);
    RESC(alA); __syncthreads();
  }
  SBAR(); qkt<QL, FIX>(pB0, pB1, (bf16_t*)((char*)K_lds + SHM_K), qr, qaddr, r32, hi, negm);
  finishSM<FIX>(pA0, pA1, alA, l_reg, pa0, pa1, pa2, pa3); SBAR();
  pv_d0<FIX>(o, vb0, pa0, pa1, pa2, pa3);
  if (WIN) partialSM<true>(pB0, pB1, m_reg, mnB, alB, DMJ(NT - 1), hi); else partialSM<false, FIX>(pB0, pB1, m_reg, mnB, alB, 0, hi);
  __syncthreads(); RESC(alB);
  finishSM<FIX>(pB0, pB1, alB, l_reg, pa0, pa1, pa2, pa3); SBAR();
  pv_d0<FIX>(o, vb0 + (int)SHM_V, pa0, pa1, pa2, pa3);
  }
  if (FIX) { auto rr = __builtin_amdgcn_permlane32_swap(__float_as_uint(l_reg), __float_as_uint(l_reg), false, false); l_reg = __uint_as_float(rr[0]) + __uint_as_float(rr[1]); }
  if (hi == 0) li_l[r32] = l_reg; asm volatile("s_waitcnt lgkmcnt(0)" ::: "memory");
  float rli[16];
#pragma unroll
  for (int r = 0; r < 16; ++r) rli[r] = __builtin_amdgcn_rcpf(li_l[crow(r, hi)]);
  bf16_t* Ow = Ob + (long)(wid * QBLK) * LDQ;
#pragma unroll
  for (int r = 0; r < 16; ++r) { int orow = crow(r, hi);
#pragma unroll
    for (int d0 = 0; d0 < 4; ++d0) Ow[(long)orow * LDQ + d0 * 32 + r32] = f2bf(o[d0][r] * rli[r]); }
  __syncthreads();
#undef KROW
#undef DMJ
#undef SLOAD
#undef SWRITE
#undef SWAIT
#undef RESC
}

template <int OFF> __device__ __forceinline__ void dft_blk2(f32x16& a0, f32x16& a1, int vb, bf16x8 u0, bf16x8 u1, bf16x8 u2, bf16x8 u3, bf16x8 w0, bf16x8 w1, bf16x8 w2, bf16x8 w3) {
  const s16x4 l0 = tr_read<OFF + v_rd_off(0, 0, 0)>(vb), h0 = tr_read<OFF + v_rd_off(0, 0, 1)>(vb), l1 = tr_read<OFF + v_rd_off(0, 1, 0)>(vb), h1 = tr_read<OFF + v_rd_off(0, 1, 1)>(vb);
  const s16x4 l2 = tr_read<OFF + v_rd_off(0, 2, 0)>(vb), h2 = tr_read<OFF + v_rd_off(0, 2, 1)>(vb), l3 = tr_read<OFF + v_rd_off(0, 3, 0)>(vb), h3 = tr_read<OFF + v_rd_off(0, 3, 1)>(vb);
  asm volatile("s_waitcnt lgkmcnt(0)" ::: "memory"); SBAR();
  a0 = __builtin_amdgcn_mfma_f32_32x32x16_bf16(u0, PKLH(l0, h0), a0, 0, 0, 0); a1 = __builtin_amdgcn_mfma_f32_32x32x16_bf16(w0, PKLH(l0, h0), a1, 0, 0, 0);
  a0 = __builtin_amdgcn_mfma_f32_32x32x16_bf16(u1, PKLH(l1, h1), a0, 0, 0, 0); a1 = __builtin_amdgcn_mfma_f32_32x32x16_bf16(w1, PKLH(l1, h1), a1, 0, 0, 0);
  a0 = __builtin_amdgcn_mfma_f32_32x32x16_bf16(u2, PKLH(l2, h2), a0, 0, 0, 0); a1 = __builtin_amdgcn_mfma_f32_32x32x16_bf16(w2, PKLH(l2, h2), a1, 0, 0, 0);
  a0 = __builtin_amdgcn_mfma_f32_32x32x16_bf16(u3, PKLH(l3, h3), a0, 0, 0, 0); a1 = __builtin_amdgcn_mfma_f32_32x32x16_bf16(w3, PKLH(l3, h3), a1, 0, 0, 0);
}
template <int STAGE>
__device__ __forceinline__ void dft_phase(const bf16_t* __restrict__ inR, const bf16_t* __restrict__ inI, bf16_t* outR, bf16_t* outI, const f32x2* __restrict__ TW, const bf16x8* __restrict__ WT, int vcu, int G, char* lds, int tid_in) {
  int tid_o = tid_in; asm volatile("" : "+v"(tid_o));
  const int tid = tid_o, wid = tid >> 6, lane = tid & 63, r32 = lane & 31, hi = lane >> 5, kr = wid & 3, dh = wid >> 2;
  bf16x8 Wc[8], Ws[8];
#pragma unroll
  for (int ks = 0; ks < 8; ++ks) { Wc[ks] = WT[((kr * 8 + ks) * 64 + lane) * 2]; Ws[ks] = WT[((kr * 8 + ks) * 64 + lane) * 2 + 1]; }
  const int sr = tid >> 4, sc = (tid & 15) * 8;
  int vst[4];
#pragma unroll
  for (int i = 0; i < 4; ++i) vst[i] = (i >> 1) * 16384 + v_st((i & 1) * 32 + sr, sc);
  const int vb = (int)(uintptr_t)lds + v_rd_base(lane) + dh * 1024;
  bf16x8 stR[4], stI[4];
  constexpr int NTILES = NB * 128 * 8;
#define DLOAD(it_) do { const int b_ = (it_) >> 10, s_ = ((it_) >> 3) & 127, c0_ = ((it_) & 7) * 128; \
    _Pragma("unroll") for (int i = 0; i < 4; ++i) { const int j_ = i * 32 + sr; const long row_ = (STAGE == 1) ? ((long)b_ * SEQ + 128 * j_ + s_) : ((long)b_ * SEQ + 128 * s_ + j_); \
      stR[i] = *reinterpret_cast<const bf16x8*>(inR + row_ * DM + c0_ + sc); if (STAGE == 2) stI[i] = *reinterpret_cast<const bf16x8*>(inI + row_ * DM + c0_ + sc); } } while (0)
  int it = vcu;
  if (it < NTILES) DLOAD(it);
  for (; it < NTILES; it += G) {
    const int b = it >> 10, s = (it >> 3) & 127, c0 = (it & 7) * 128;
#pragma unroll
    for (int i = 0; i < 4; ++i) { *(bf16x8*)(lds + vst[i]) = stR[i]; if (STAGE == 2) *(bf16x8*)(lds + 32768 + vst[i]) = stI[i]; }
    __syncthreads();
    if (it + G < NTILES) DLOAD(it + G);
    bf16_t* stg = (bf16_t*)(lds + 65536 + wid * 8192);
    const bool active = !(STAGE == 2 && HERM && kr >= 2);
#define DFT_DD(DDOFF, DD) do { if (active) { f32x16 aR = {}, aI = {}; \
    dft_blk2<DDOFF>(aR, aI, vb, Wc[0], Wc[1], Wc[2], Wc[3], Ws[0], Ws[1], Ws[2], Ws[3]); \
    dft_blk2<16384 + DDOFF>(aR, aI, vb, Wc[4], Wc[5], Wc[6], Wc[7], Ws[4], Ws[5], Ws[6], Ws[7]); \
    if (STAGE == 2) { aI = -aI; \
      dft_blk2<32768 + DDOFF>(aI, aR, vb, Wc[0], Wc[1], Wc[2], Wc[3], Ws[0], Ws[1], Ws[2], Ws[3]); \
      dft_blk2<32768 + 16384 + DDOFF>(aI, aR, vb, Wc[4], Wc[5], Wc[6], Wc[7], Ws[4], Ws[5], Ws[6], Ws[7]); } \
    _Pragma("unroll") for (int r = 0; r < 16; ++r) { const int rw = crow(r, hi); float tc = 1.f, ts = 0.f; \
      if (STAGE == 1) { const f32x2 tw = TW[s * 128 + 32 * kr + rw]; tc = tw.x; ts = tw.y; } \
      const float oc = aR[r], os = aI[r]; \
      const float vr = (STAGE == 1) ? (oc * tc - os * ts) : oc, vi = (STAGE == 1) ? -(oc * ts + os * tc) : os; \
      stg[rw * 64 + DD * 32 + r32] = f2bf(vr); stg[2048 + rw * 64 + DD * 32 + r32] = f2bf(vi); } } } while (0)
    DFT_DD(0, 0); DFT_DD(512, 1);
#undef DFT_DD
    asm volatile("s_waitcnt lgkmcnt(0)" ::: "memory");
    if (active) { const int ch = lane & 7, colb = c0 + 64 * dh + ch * 8;
#pragma unroll
      for (int i = 0; i < 4; ++i) { const int row = i * 8 + (lane >> 3), ro = 32 * kr + row;
        const u32x4 vr = *(const u32x4*)(stg + row * 64 + ch * 8), vi = *(const u32x4*)(stg + 2048 + row * 64 + ch * 8);
        if (STAGE == 1) { const long orow = (long)b * SEQ + ro * 128 + s; *(u32x4*)(outR + orow * DM + colb) = vr; *(u32x4*)(outI + orow * DM + colb) = vi; }
        else if (HERM) { const long orow = (long)b * (SEQ / 2) + s + 128 * ro; *(u32x4*)(outR + orow * DM + colb) = vr; *(u32x4*)(outI + orow * DM + colb) = vi; }
        else { const long orow = (long)b * SEQ + s + 128 * ro; const int g = colb >> 8, cl = colb & 255; *(u32x4*)(outR + orow * 2048 + 512 * g + cl) = vr; *(u32x4*)(outR + orow * 2048 + 512 * g + 256 + cl) = vi; } } }
    asm volatile("s_waitcnt lgkmcnt(0)" ::: "memory");
    __syncthreads();
  }
#undef DLOAD
}
#undef SBAR
#undef KSWZ
}

struct Args {
    const float *x, *c, *ctx, *c_ctx, *mod_w, *mod_b, *norm_g, *w_in, *w_out, *q_g, *k_g, *sink, *w_f, *w_up, *conv_w, *conv_b, *w_down;
    float* out; unsigned char* ws;
};

template <bool HPERM = false>
__device__ __forceinline__ void transpose_item(const float* W, int K, int N, bf16_t* WT, int k0, int n0, int drow0, LAS float* scr, int lane) {
#pragma unroll 8
    for (int i = 0; i < 32; ++i) { const int kk = 2 * i + (lane >> 5); scr[kk * 33 + (lane & 31)] = W[(size_t)(k0 + kk) * N + n0 + (lane & 31)]; }
    asm volatile("s_waitcnt lgkmcnt(0)" ::: "memory");
    const int c = lane & 7;
#pragma unroll
    for (int j = 0; j < 4; ++j) { const int n = (lane >> 3) + 8 * j; const LAS float* s = scr + (8 * c) * 33 + n;
        int drow = drow0 + n;
        if (HPERM) { const int L = drow0 + n, d = L & 127; drow = (L & ~127) | (d & 0x40) | ((d & 0x10) << 1) | ((d & 0x0C) << 1) | ((d & 0x20) >> 3) | (d & 3); }
        u32x4 o; o.x = cvt_pk_bf16(s[0 * 33], s[1 * 33]); o.y = cvt_pk_bf16(s[2 * 33], s[3 * 33]); o.z = cvt_pk_bf16(s[4 * 33], s[5 * 33]); o.w = cvt_pk_bf16(s[6 * 33], s[7 * 33]);
        *(u32x4*)(WT + (size_t)drow * K + k0 + 8 * c) = o; }
    asm volatile("s_waitcnt lgkmcnt(0)" ::: "memory");
}
__device__ __forceinline__ int up_row(int n) { const int half = n >= DFF ? 1 : 0, j = n - half * DFF; return 256 * (j >> 7) + 128 * half + (j & 127); }

__device__ __forceinline__ void prologue(const Args& a, int vcu, int G, unsigned char* ldsg, LAS unsigned char* lds, int tid_in) {
    int tid_o = tid_in; asm volatile("" : "+v"(tid_o));
    const int tid = tid_o, lane = tid & 63, wave = tid >> 6;
    unsigned char* ws = a.ws;
    {
        LAS float* sv = (LAS float*)lds;
        LAS float* red = (LAS float*)(lds + 16384);
        for (int i = tid; i < 3 * 1024; i += 512) { const int v = i >> 10, k = i & 1023; const float cv = (v < 2) ? a.c[v * 1024 + k] : a.c_ctx[k]; sv[i] = cv / (1.0f + __expf(-cv)); }
        __syncthreads();
        for (int job = vcu; job < 2 * 96; job += G) {
            const int l = job / 96, j0 = (job % 96) * 64;
            const float* W = a.mod_w + (size_t)l * 1024 * 6144 + j0 + lane;
            float a0 = 0.f, a1 = 0.f, a2 = 0.f;
#pragma unroll 16
            for (int i = 0; i < 128; ++i) { const int k = wave + 8 * i; const float w = W[(size_t)k * 6144]; a0 += sv[k] * w; a1 += sv[1024 + k] * w; a2 += sv[2048 + k] * w; }
            red[(wave * 3 + 0) * 64 + lane] = a0; red[(wave * 3 + 1) * 64 + lane] = a1; red[(wave * 3 + 2) * 64 + lane] = a2;
            __syncthreads();
            if (tid < 192) { const int v = tid >> 6, cc = tid & 63; float s = a.mod_b[l * 6144 + j0 + cc];
#pragma unroll
                for (int w = 0; w < 8; ++w) s += red[(w * 3 + v) * 64 + cc];
                ((float*)(ws + WS_MOD))[(l * 3 + v) * 6144 + j0 + cc] = s; }
            __syncthreads();
        }
        __syncthreads();
    }
    {
        const int gt = vcu * 512 + tid, NT_ = G * 512;
        f32x2* rope = (f32x2*)(ws + WS_ROPE); f32x2* tw = (f32x2*)(ws + WS_TW);
        for (int i = gt; i < 256 * 32; i += NT_) { const int pos = i >> 5, f = i & 31; const float inv = powf(10000.0f, -(float)f / 32.0f); const float ang = (float)pos * inv; rope[i] = (f32x2){cosf(ang), sinf(ang)}; }
        u32x4* wt = (u32x4*)(ws + WS_DFTW);
        for (int i = gt; i < 4 * 8 * 64; i += NT_) { const int ln = i & 63, ks = (i >> 6) & 7, kr_ = i >> 9; const int row = 32 * kr_ + (ln & 31); float c[8], sn[8];
#pragma unroll
            for (int e = 0; e < 8; ++e) { const int k = 16 * ks + 8 * (ln >> 5) + e; sincospif((float)((row * k) & 127) * (1.0f / 64.0f), &sn[e], &c[e]); }
            wt[2 * i] = (u32x4){cvt_pk_bf16(c[0], c[1]), cvt_pk_bf16(c[2], c[3]), cvt_pk_bf16(c[4], c[5]), cvt_pk_bf16(c[6], c[7])};
            wt[2 * i + 1] = (u32x4){cvt_pk_bf16(sn[0], sn[1]), cvt_pk_bf16(sn[2], sn[3]), cvt_pk_bf16(sn[4], sn[5]), cvt_pk_bf16(sn[6], sn[7])}; }
        for (int i = gt; i < 128 * 128; i += NT_) { const int n2 = i >> 7, k1 = i & 127; float s, c; sincospif((float)(n2 * k1) * (1.0f / 8192.0f), &s, &c); tw[i] = (f32x2){c, s}; }
    }
    {
        LAS float* scr = (LAS float*)(lds + wave * 16384);
        const int gw = vcu * 8 + wave, NGW = G * 8;
        constexpr int I_IN = 16 * 64, I_OUT = 16 * 32, I_UP = 16 * 176, I_DN = 44 * 32;
        constexpr int NITEMS = I_IN + I_OUT + 2 * I_UP + 2 * I_DN;
        for (int it = gw; it < NITEMS; it += NGW) {
            int r = it;
            if (r < I_IN) { const int kb = r / 64, nb = r % 64; const int hh = nb >> 2;
#if FUSE_QKV
                if (hh < 10 || hh == 12 || hh == 13) transpose_item<true>(a.w_in, 1024, 2048, (bf16_t*)(ws + WS_WIN), 64 * kb, 32 * nb, 32 * nb, scr, lane); else
#endif
                transpose_item(a.w_in, 1024, 2048, (bf16_t*)(ws + WS_WIN), 64 * kb, 32 * nb, 32 * nb, scr, lane); continue; } r -= I_IN;
            if (r < I_OUT) { const int kb = r / 32, nb = r % 32; transpose_item(a.w_out, 1024, 1024, (bf16_t*)(ws + WS_WOUT), 64 * kb, 32 * nb, 32 * nb, scr, lane); continue; } r -= I_OUT;
            if (r < 2 * I_UP) { const int l = r / I_UP, q = r % I_UP, kb = q / 176, nb = q % 176;
                transpose_item(a.w_up + (size_t)l * 1024 * NUP, 1024, NUP, (bf16_t*)(ws + (l ? WS_WUP1 : WS_WUP0)), 64 * kb, 32 * nb, up_row(32 * nb), scr, lane); continue; } r -= 2 * I_UP;
            { const int l = r / I_DN, q = r % I_DN, kb = q / 32, nb = q % 32;
                transpose_item(a.w_down + (size_t)l * DFF * 1024, DFF, 1024, (bf16_t*)(ws + (l ? WS_WDN1 : WS_WDN0)), 64 * kb, 32 * nb, 32 * nb, scr, lane); }
        }
    }
    {
        LAS float* cT = (LAS float*)(lds + LDS_XCH); LAS float* sT = cT + 256;
        if (tid < 256) { float s, c; sincospif((float)tid * (1.0f / 128.0f), &s, &c); cT[tid] = c; sT[tid] = s; }
        __syncthreads();
        const int gw = vcu * 8 + wave, NGW = G * 8;
        bf16_t* WP = (bf16_t*)(ws + WS_WP);
        for (int it = gw; it < 4 * 64 * 16; it += NGW) {
            const int g = it >> 10, cb = (it >> 4) & 63, nb = it & 15, n = nb * 64 + lane;
            const LAS float* tab = (cb < 32) ? cT : sT; const int cp0 = (cb & 31) * 8;
            float acc[8] = {0.f, 0.f, 0.f, 0.f, 0.f, 0.f, 0.f, 0.f};
            const float* wf = a.w_f + (size_t)(256 * g) * 1024 + n;
            for (int kb = 0; kb < 256; kb += 32) { float wv[32];
#pragma unroll
                for (int q = 0; q < 32; ++q) wv[q] = wf[(size_t)(kb + q) * 1024];
#pragma unroll
                for (int q = 0; q < 32; ++q) {
#pragma unroll
                    for (int j = 0; j < 8; ++j) acc[j] += tab[((cp0 + j) * (kb + q)) & 255] * wv[q]; } }
            const float sc = 1.0f / 2048.0f;
            u32x4 o; o.x = cvt_pk_bf16(acc[0] * sc, acc[1] * sc); o.y = cvt_pk_bf16(acc[2] * sc, acc[3] * sc); o.z = cvt_pk_bf16(acc[4] * sc, acc[5] * sc); o.w = cvt_pk_bf16(acc[6] * sc, acc[7] * sc);
#if HERM
            *(u32x4*)((bf16_t*)(ws + (cb < 32 ? WS_WC : WS_WS)) + (size_t)n * 1024 + 256 * g + (cb & 31) * 8) = o;
#else
            *(u32x4*)(WP + (size_t)n * 2048 + 512 * g + cb * 8) = o;
#endif
        }
    }
}

__device__ __forceinline__ void norm_mod_rows(const float* src, int row0, int nrows, bf16_t* XN, int xrow0, const float* g, const float* sh, const float* sc, int gw, int NGW, int lane) {
    f32x4 A[4], B[4];
#pragma unroll
    for (int j = 0; j < 4; ++j) { const int c = 4 * lane + 256 * j; const f32x4 gv = *(const f32x4*)(g + c), sv = *(const f32x4*)(sc + c); A[j] = gv * (sv + 1.0f); B[j] = *(const f32x4*)(sh + c); }
    for (int m = gw; m < nrows; m += NGW) {
        const f32x4* xr = (const f32x4*)(src + (size_t)(row0 + m) * DM) + lane;
        f32x4 v[4]; float s = 0.f;
#pragma unroll
        for (int j = 0; j < 4; ++j) { v[j] = xr[64 * j]; s += (v[j].x * v[j].x + v[j].y * v[j].y) + (v[j].z * v[j].z + v[j].w * v[j].w); }
        const float r = rsqrtf(wave_sum(s) * (1.0f / DM) + EPS);
        u32x2* o8 = (u32x2*)(XN + (size_t)(xrow0 + m) * DM) + lane;
#pragma unroll
        for (int j = 0; j < 4; ++j) { const f32x4 h = v[j] * r * A[j] + B[j]; u32x2 w; w.x = cvt_pk_bf16(h.x, h.y); w.y = cvt_pk_bf16(h.z, h.w); o8[64 * j] = w; }
    }
}

template <bool WRITE_XN, bool XIN_F32, bool XOUT_F32, bool YSYM = false>
__device__ __forceinline__ void residual_rows(const float* xin, bf16_t* XRES, const bf16_t* Y, float* xout, bf16_t* XN, int row0, int nrows, const float* gY, const float* gate, const float* gN, const float* sh, const float* sc, int gw, int NGW, int lane_in, const float* ynyq = nullptr) {
    int lane = lane_in; asm volatile("" : "+v"(lane));
    constexpr int RR = XIN_F32 ? 2 : RES_ROWS;
    f32x4 GA[4], A[4], B[4];
#pragma unroll
    for (int j = 0; j < 4; ++j) { const int c = 4 * lane + 256 * j; GA[j] = *(const f32x4*)(gY + c) * *(const f32x4*)(gate + c);
        if (WRITE_XN) { A[j] = *(const f32x4*)(gN + c) * (*(const f32x4*)(sc + c) + 1.0f); B[j] = *(const f32x4*)(sh + c); } }
    static_assert(!YSYM || RR == 2, "the mirrored-pair mapping handles two rows per trip");
    const int mstep = YSYM ? NGW : RR * NGW, mend = YSYM ? nrows / 2 : nrows;
    for (int m = gw; m < mend; m += mstep) {
        size_t ro[RR]; bool ok[RR]; f32x4 yv[RR][4]; f32x4 xv[RR][4];
#pragma unroll
        for (int q = 0; q < RR; ++q) {
            if (YSYM) { const int t = (q == 0) ? m : (m == 0 ? SEQ / 2 : SEQ - m); ok[q] = true; ro[q] = (size_t)(row0 + t) * DM; }
            else { ok[q] = (m + q * NGW) < nrows; ro[q] = (size_t)(row0 + (ok[q] ? m + q * NGW : m)) * DM; } }
        if (YSYM) { const int bq = row0 / SEQ; const size_t ru = (size_t)(bq * (SEQ / 2) + m) * DM;
#pragma unroll
            for (int j = 0; j < 4; ++j) { const u32x2 wu = ((const u32x2*)(Y + ru) + lane)[64 * j], wv = ((const u32x2*)(Y + (size_t)MTOK / 2 * DM + ru) + lane)[64 * j];
                const f32x4 uf = {bf_lo(wu.x), bf_hi(wu.x), bf_lo(wu.y), bf_hi(wu.y)}, vf = {bf_lo(wv.x), bf_hi(wv.x), bf_lo(wv.y), bf_hi(wv.y)};
                yv[0][j] = uf + vf; yv[RR - 1][j] = uf - vf;
                if (m == 0) yv[RR - 1][j] = ((const f32x4*)(ynyq + bq * 1024) + lane)[64 * j]; } }
#pragma unroll
        for (int q = 0; q < RR; ++q)
#pragma unroll
            for (int j = 0; j < 4; ++j) {
                if (YSYM) {
                } else { const u32x2 w_ = ((const u32x2*)(Y + ro[q]) + lane)[64 * j]; yv[q][j] = (f32x4){bf_lo(w_.x), bf_hi(w_.x), bf_lo(w_.y), bf_hi(w_.y)}; }
                if (XIN_F32) xv[q][j] = ((const f32x4*)(xin + ro[q]) + lane)[64 * j];
                else { const u32x2 a = ((const u32x2*)(XRES + ro[q]) + lane)[64 * j]; xv[q][j] = (f32x4){bf_lo(a.x), bf_hi(a.x), bf_lo(a.y), bf_hi(a.y)}; } }
        float s[RR];
#pragma unroll
        for (int q = 0; q < RR; ++q) { s[q] = 0.f;
#pragma unroll
            for (int j = 0; j < 4; ++j) { const f32x4 y = yv[q][j]; s[q] += (y.x * y.x + y.y * y.y) + (y.z * y.z + y.w * y.w); } }
#pragma unroll
        for (int o = 1; o < 64; o <<= 1) {
#pragma unroll
            for (int q = 0; q < RR; ++q) s[q] += __shfl_xor(s[q], o); }
        float qs[RR];
#pragma unroll
        for (int q = 0; q < RR; ++q) { const float r = rsqrtf(s[q] * (1.0f / DM) + EPS); qs[q] = 0.f;
#pragma unroll
            for (int j = 0; j < 4; ++j) { const f32x4 y = yv[q][j];
                xv[q][j] = xv[q][j] + y * r * GA[j];
                if (ok[q]) { if (XOUT_F32) ((f32x4*)(xout + ro[q]) + lane)[64 * j] = xv[q][j];
                             else { u32x2 a; a.x = cvt_pk_bf16(xv[q][j].x, xv[q][j].y); a.y = cvt_pk_bf16(xv[q][j].z, xv[q][j].w); ((u32x2*)(XRES + ro[q]) + lane)[64 * j] = a; } }
                qs[q] += (xv[q][j].x * xv[q][j].x + xv[q][j].y * xv[q][j].y) + (xv[q][j].z * xv[q][j].z + xv[q][j].w * xv[q][j].w); } }
        if (WRITE_XN) {
#pragma unroll
            for (int o = 1; o < 64; o <<= 1) {
#pragma unroll
                for (int q = 0; q < RR; ++q) qs[q] += __shfl_xor(qs[q], o); }
#pragma unroll
            for (int q = 0; q < RR; ++q) { const float t = rsqrtf(qs[q] * (1.0f / DM) + EPS);
#pragma unroll
                for (int j = 0; j < 4; ++j) { const f32x4 h = xv[q][j] * t * A[j] + B[j]; u32x2 a; a.x = cvt_pk_bf16(h.x, h.y); a.y = cvt_pk_bf16(h.z, h.w);
                    if (ok[q]) ((u32x2*)(XN + ro[q]) + lane)[64 * j] = a; } }
        }
    }
}
__device__ __forceinline__ void residual_phase(const Args& a, int l, int which, int gw, int NGW, int lane) {
    const float* MOD = (const float*)(a.ws + WS_MOD); bf16_t* XN = (bf16_t*)(a.ws + WS_XN); const bf16_t* Y = (const bf16_t*)(a.ws + WS_Y); bf16_t* XR = (bf16_t*)(a.ws + WS_XRES);
    for (int b = 0; b < NB; ++b) {
        const float* mb = MOD + (size_t)(l * 3 + b) * 6144;
        if (which == 0) {
            if (l == 0) residual_rows<true, true, false>(a.x, XR, Y, a.out, XN, b * SEQ, SEQ, a.norm_g + (l * 4 + 1) * DM, mb + 2 * DM, a.norm_g + (l * 4 + 2) * DM, mb + 3 * DM, mb + 4 * DM, gw, NGW, lane);
            else        residual_rows<true, false, false, (HERM != 0)>(a.x, XR, Y, a.out, XN, b * SEQ, SEQ, a.norm_g + (l * 4 + 1) * DM, mb + 2 * DM, a.norm_g + (l * 4 + 2) * DM, mb + 3 * DM, mb + 4 * DM, gw, NGW, lane, (const float*)(a.ws + WS_YNY));
        } else if (l == 0) { const float* mn = MOD + (size_t)(3 + b) * 6144;
            residual_rows<true, false, false>(a.x, XR, Y, a.out, XN, b * SEQ, SEQ, a.norm_g + (l * 4 + 3) * DM, mb + 5 * DM, a.norm_g + 4 * DM, mn + 0 * DM, mn + 1 * DM, gw, NGW, lane); }
        else residual_rows<false, false, true>(a.x, XR, Y, a.out, XN, b * SEQ, SEQ, a.norm_g + (l * 4 + 3) * DM, mb + 5 * DM, nullptr, nullptr, nullptr, gw, NGW, lane);
    }
}

__device__ __forceinline__ void qkv_post(const Args& a, int m_lo, int m_hi, int gw, int NGW, int lane, int jsel, int halfsel) {
    const bf16_t* PROJ = (const bf16_t*)(a.ws + WS_PROJ); bf16_t* Q = (bf16_t*)(a.ws + WS_Q);
    const f32x2* rope = (const f32x2*)(a.ws + WS_ROPE);
    const int l16 = lane & 15, d0 = 8 * l16, ax = l16 >> 3, half = (l16 >> 2) & 1, f0 = 8 * (lane & 3);
    float qg[8], kg[8];
#pragma unroll
    for (int e = 0; e < 8; ++e) { qg[e] = a.q_g[d0 + e]; kg[e] = a.k_g[d0 + e]; }
    for (int m = m_lo + gw; m < m_hi; m += NGW) {
        const bool isctx = m >= MTOK; const int b = isctx ? ((m - MTOK) >> 8) : (m >> 14); const int t = isctx ? ((m - MTOK) & 255) : (m & (SEQ - 1));
        const int pos = ax ? (t & 63) : (t >> 6);
        float cs[8], sn[8];
        if (!isctx) {
#pragma unroll
            for (int e = 0; e < 8; e += 2) { const f32x4 v = *(const f32x4*)(rope + pos * 32 + f0 + e); cs[e] = v.x; sn[e] = v.y; cs[e + 1] = v.z; sn[e + 1] = v.w; }
        }
#pragma unroll
        for (int j = 0; j < 4; ++j) {
            if ((isctx && j < 2) || (jsel >= 0 && j != jsel)) continue;
            const u32x4 w = *(const u32x4*)(PROJ + (size_t)m * NPROJ + 512 * j + 8 * lane);
            float x[8] = {bf_lo(w.x), bf_hi(w.x), bf_lo(w.y), bf_hi(w.y), bf_lo(w.z), bf_hi(w.z), bf_lo(w.w), bf_hi(w.w)};
            const int hh = 4 * j + (lane >> 4);
            float ss = 0.f;
#pragma unroll
            for (int e = 0; e < 8; ++e) ss += x[e] * x[e];
            ss += __shfl_xor(ss, 1); ss += __shfl_xor(ss, 2); ss += __shfl_xor(ss, 4); ss += __shfl_xor(ss, 8);
            const float r = rsqrtf(ss * (1.0f / HD) + EPS);
            const bool isq = hh < 4, isk = (hh == 8 || hh == 9);
            if (isq || isk) {
#pragma unroll
                for (int e = 0; e < 8; ++e) x[e] = x[e] * r * (isq ? qg[e] : kg[e]); }
            const bool dorope = !isctx && (hh < 10 || hh == 12 || hh == 13);
#pragma unroll
            for (int e = 0; e < 8; ++e) { const float p = __shfl_xor(x[e], 4); const float rot = half ? (x[e] * cs[e] + p * sn[e]) : (x[e] * cs[e] - p * sn[e]); if (dorope) x[e] = rot; }
            u32x4 o; o.x = cvt_pk_bf16(x[0], x[1]); o.y = cvt_pk_bf16(x[2], x[3]); o.z = cvt_pk_bf16(x[4], x[5]); o.w = cvt_pk_bf16(x[6], x[7]);
            bf16_t* dst;
            if (hh < 8) dst = Q + (size_t)m * DM + hh * HD + d0;
            else { const int sel = (hh - 8) >> 1, kvh = (hh - 8) & 1; dst = (bf16_t*)(a.ws + WS_KA + (size_t)sel * KV_BYTES) + ((size_t)(b * 2 + kvh) * SKV + (isctx ? t : CTXL + t)) * HD + d0; }
            if (halfsel < 0 || (lane >> 5) == halfsel) *(u32x4*)dst = o;
        }
    }
}

__device__ __forceinline__ void ctx_tile_post(const Args& a, int b, int pn, int wave, int lane) {
    const bf16_t* __restrict__ PROJ = (const bf16_t*)(a.ws + WS_PROJ);
    bf16_t* __restrict__ KVb = (bf16_t*)(a.ws + WS_KA + (size_t)(pn - 4) * KV_BYTES);
    const int l32 = lane & 31, head = l32 >> 4, d0 = 8 * (l32 & 15), c0 = 1024 + 256 * (pn - 4);
    float kg[8];
#pragma unroll
    for (int e = 0; e < 8; ++e) kg[e] = (pn == 4) ? a.k_g[d0 + e] : 1.0f;
#pragma unroll 4
    for (int i = 0; i < 16; ++i) {
        const int r = wave * 32 + 2 * i + (lane >> 5); const size_t m = (size_t)MTOK + 256 * b + r;
        const u32x4 w = *(const u32x4*)(PROJ + m * NPROJ + c0 + 8 * l32);
        float x[8] = {bf_lo(w.x), bf_hi(w.x), bf_lo(w.y), bf_hi(w.y), bf_lo(w.z), bf_hi(w.z), bf_lo(w.w), bf_hi(w.w)};
        float ss = 0.f;
#pragma unroll
        for (int e = 0; e < 8; ++e) ss += x[e] * x[e];
        ss += __shfl_xor(ss, 1); ss += __shfl_xor(ss, 2); ss += __shfl_xor(ss, 4); ss += __shfl_xor(ss, 8);
        const float rn = (pn == 4) ? rsqrtf(ss * (1.0f / HD) + EPS) : 1.0f;
#pragma unroll
        for (int e = 0; e < 8; ++e) x[e] = x[e] * rn * kg[e];
        u32x4 o; o.x = cvt_pk_bf16(x[0], x[1]); o.y = cvt_pk_bf16(x[2], x[3]); o.z = cvt_pk_bf16(x[4], x[5]); o.w = cvt_pk_bf16(x[6], x[7]);
        *(u32x4*)(KVb + ((size_t)(b * 2 + head) * SKV + r) * HD + d0) = o;
    }
}

#ifndef PH
#define PH 0xFFFF
#endif
typedef unsigned gu32_unused_t;
#define RLX_AGENT __ATOMIC_RELAXED, __HIP_MEMORY_SCOPE_AGENT
#define XB_TMO      128
#define XB_XCNT(j)  (256  + 64 * (j))
#define XB_XSUB(j)  (1280 + 64 * (j))
#define XB_XGEN(j)  (2304 + 64 * (j))
#define XB_TOP      3328
#define XB_TOPGEN   3392
#define XCD_BAR_WORDS 3456
#define XB_SPIN_CAP (1u << 18)

__device__ __forceinline__ unsigned xb_ld(unsigned* p)              { return __hip_atomic_load(p, __ATOMIC_RELAXED, __HIP_MEMORY_SCOPE_AGENT); }
__device__ __forceinline__ unsigned xb_add(unsigned* p, unsigned v) { return __hip_atomic_fetch_add(p, v, __ATOMIC_RELAXED, __HIP_MEMORY_SCOPE_AGENT); }
__device__ __forceinline__ unsigned xb_xcc_id() { return (unsigned)__builtin_amdgcn_s_getreg((3 << 11) | 20) & 0xFu; }
#define XB_SPIN(cond, bar) do { unsigned _sp = 0; while (cond) { __builtin_amdgcn_s_sleep(1); \
    if ((++_sp & 255u) == 0u) { if (xb_ld(&(bar)[XB_TMO])) break; if (_sp > XB_SPIN_CAP) { atomicAdd(&(bar)[XB_TMO], 1u); break; } } } } while (0)

struct XcdBarrier {
    unsigned* bar; unsigned x;
    volatile LAS unsigned* st;
};

__device__ __forceinline__ XcdBarrier xcd_barrier_post(unsigned* bar, volatile LAS unsigned* st, bool t0) {
    XcdBarrier b; b.bar = bar; b.x = xb_xcc_id(); b.st = st;
    if (t0) (void)xb_add(&bar[XB_XCNT(b.x)], 1u);
    return b;
}
__device__ __forceinline__ void xcd_barrier_complete(unsigned* bar, unsigned x, unsigned& nloc, unsigned& nx) {
    const unsigned G = gridDim.x * gridDim.y * gridDim.z;
    unsigned sum, cnt, mine, sp = 0u;
    for (;;) {
        sum = 0u; cnt = 0u; mine = 0u;
#pragma unroll
        for (unsigned j = 0; j < 16; ++j) { const unsigned c = xb_ld(&bar[XB_XCNT(j)]); sum += c; cnt += (c > 0u) ? 1u : 0u; mine = (j == x) ? c : mine; }
        if (sum == G) break;
        __builtin_amdgcn_s_sleep(1);
        if ((++sp & 255u) == 0u) { if (xb_ld(&bar[XB_TMO])) break; if (sp > XB_SPIN_CAP) { atomicAdd(&bar[XB_TMO], 1u); break; } }
    }
    nloc = mine > 0u ? mine : 1u; nx = cnt > 0u ? cnt : 1u;
}

__device__ __forceinline__ void xcd_barrier(const XcdBarrier& b, int wave_s) {
    asm volatile("s_waitcnt vmcnt(0)" ::: "memory");
    __syncthreads();
    int l0_ = 1; if (wave_s == 0) asm volatile("v_mbcnt_lo_u32_b32 %0, -1, 0" : "=v"(l0_));
    if (wave_s == 0 && l0_ == 0) {
        unsigned* bar = b.bar;
        __builtin_amdgcn_s_waitcnt(0);
        unsigned nloc = b.st[0], nx = b.st[1];
        if (nloc == 0u) { xcd_barrier_complete(bar, b.x, nloc, nx); b.st[0] = nloc; b.st[1] = nx; }
        const unsigned old = xb_add(&bar[XB_XSUB(b.x)], 1u);
        const unsigned gen = old / nloc;
        if (old + 1u == (gen + 1u) * nloc) {
            __builtin_amdgcn_fence(__ATOMIC_RELEASE, "agent");
            asm volatile("s_waitcnt vmcnt(0)" ::: "memory");
            const unsigned og = xb_add(&bar[XB_TOP], 1u);
            const unsigned tg = og / nx;
            if (og + 1u == (tg + 1u) * nx) xb_add(&bar[XB_TOPGEN], 1u);
            else XB_SPIN(xb_ld(&bar[XB_TOPGEN]) == tg, bar);
            __builtin_amdgcn_fence(__ATOMIC_ACQUIRE, "agent");
            xb_add(&bar[XB_XGEN(b.x)], 1u);
            asm volatile("s_waitcnt vmcnt(0)" ::: "memory");
        } else {
            XB_SPIN(xb_ld(&bar[XB_XGEN(b.x)]) == gen, bar);
            __builtin_amdgcn_fence(__ATOMIC_ACQUIRE, "agent");
            asm volatile("s_waitcnt vmcnt(0)" ::: "memory");
        }
    }
    __syncthreads();
}


#define GRID_SEAM() xcd_barrier(xbar, wave_s)
#define PHASE_PRELUDE \
        int tid_o; asm volatile("v_mbcnt_lo_u32_b32 %0, -1, 0\n\tv_mbcnt_hi_u32_b32 %0, -1, %0\n\tv_add_u32 %0, %1, %0" : "=&v"(tid_o) : "s"(wave_s * 64)); \
        int vcu = vcu0; asm volatile("" : "+s"(vcu)); \
        const int tid = tid_o, lane = tid & 63, wave = tid >> 6, gw = vcu * 8 + wave; (void)tid; \
        const Args& a = a_k; unsigned char* ws = a.ws; \
        const float* MOD = (const float*)(ws + WS_MOD); bf16_t* XN = (bf16_t*)(ws + WS_XN); bf16_t* Y = (bf16_t*)(ws + WS_Y);
__global__ void __launch_bounds__(512, 2) fwd_megakernel(Args a_k) {
    extern __shared__ __attribute__((aligned(16))) unsigned char ldsraw[];
    cg::grid_group grid = cg::this_grid();
    LAS unsigned char* lds = (LAS unsigned char*)ldsraw;
    const int G = gridDim.x; const int bx = blockIdx.x; const int vcu0 = (G % 8 == 0) ? (bx % 8) * (G / 8) + bx / 8 : bx;
    const int NGW = G * 8;
    const int wave_s = __builtin_amdgcn_readfirstlane((int)threadIdx.x >> 6);
    { volatile LAS unsigned* st0 = (volatile LAS unsigned*)(lds + LDS_MISC); if (threadIdx.x < 2) st0[threadIdx.x] = 0u; }
    __syncthreads();
    const XcdBarrier xbar = xcd_barrier_post((unsigned*)(a_k.ws + WS_CTL), (volatile LAS unsigned*)(lds + LDS_MISC), threadIdx.x == 0);
    constexpr int NPH = 17;
#pragma nounroll
    for (int ph = 0; ph < NPH; ++ph) {
        const int kinds = (ph == 0) ? 0 : (ph == 1) ? 1 : (ph == 3) ? 3 : (ph == 4) ? 4 : (ph == 10) ? 7 : (ph == 11) ? 8 : (ph == 7 || ph == 14) ? 6 : (ph == 6 || ph == 9 || ph == 13 || ph == 16) ? 5 : 2;
#ifdef EXPMASK
        const int reps = ((EXPMASK >> ph) & 1) ? 2 : 1;
#else
        const int reps = 1;
#endif
#if FUSE_QKV
        if (ph == 3) continue;
#endif
#pragma nounroll
        for (int rep = 0; rep < reps; ++rep) {
        if (rep) __syncthreads();
#if FUSE_QKV
        if (ph == 2) { PHASE_PRELUDE
            pg8::Gemm g{XN, (const bf16_t*)(ws + WS_WIN), 1024, 256}; pg8::StaticOrder S; S.init(MALL / 256, NPROJ / 256, G, bx);
            pg8::EpiQKV E{(bf16_t*)(ws + WS_Q), (bf16_t*)(ws + WS_KA), a.q_g, a.k_g, (const f32x2*)(ws + WS_ROPE), lds + LDS_XCH};
            pg8::gemm_phase<pg8::EpiQKV, pg8::StaticOrder, true, true>(lds, g, S, E, tid);
        } else
#endif
        if (kinds == 0) { PHASE_PRELUDE
#if PH & 1
            prologue(a, vcu, G, ldsraw, lds, tid);
#endif
        } else if (kinds == 1) { PHASE_PRELUDE
#if PH & 2
            for (int b = 0; b < NB; ++b) norm_mod_rows(a.x, b * SEQ, SEQ, XN, b * SEQ, a.norm_g, MOD + (size_t)b * 6144, MOD + (size_t)b * 6144 + DM, gw, NGW, lane);
            norm_mod_rows(a.ctx, 0, NB * CTXL, XN, MTOK, a.norm_g, MOD + (size_t)2 * 6144, MOD + (size_t)2 * 6144 + DM, gw, NGW, lane);
#endif
        } else if (kinds == 2 || (CTX_IN_P3 && ph == 3 && bx < 8)) { PHASE_PRELUDE
#if PH & 4
            const bf16_t* A; const bf16_t* Bt; bf16_t* O; int K, nM, nN, ldc;
            if (ph == 2 || ph == 3) { A = XN; Bt = (const bf16_t*)(ws + WS_WIN); O = (bf16_t*)(ws + WS_PROJ); K = 1024; nM = (CTX_IN_P3 && ph == 2) ? MTOK / 256 : MALL / 256; nN = NPROJ / 256; ldc = NPROJ; }
            else if (ph == 5)  { A = (const bf16_t*)(ws + WS_O); Bt = (const bf16_t*)(ws + WS_WOUT); O = Y; K = 1024; nM = MTOK / 256; nN = 4; ldc = DM; }
#if HERM
            else if (ph == 12) { A = (const bf16_t*)(ws + WS_XR); Bt = (const bf16_t*)(ws + WS_WC); O = Y; K = 1024; nM = MTOK / 256; nN = 4; ldc = DM; }
#else
            else if (ph == 12) { A = (const bf16_t*)(ws + WS_A2); Bt = (const bf16_t*)(ws + WS_WP); O = Y; K = 2048; nM = MTOK / 256; nN = 4; ldc = DM; }
#endif
            else               { A = (const bf16_t*)(ws + WS_ACT); Bt = (const bf16_t*)(ws + (ph == 15 ? WS_WDN1 : WS_WDN0)); O = Y; K = DFF; nM = MTOK / 256; nN = 4; ldc = DM; }
            pg8::Gemm g{A, Bt, K, 256}; pg8::StaticOrder S; S.init(nM, nN, G, bx);
            if (ph == 3) { S.fpm = MTOK / 256 + (bx >> 2); S.fpn = 4 + (bx & 3); }
#if HERM
            if (ph == 12) { g.msplit = 64; g.bsplit = (size_t)(WS_WS - WS_WC); }
#endif
#if CONV_ALIGNED
            if (ph == 8 || ph == 15) {
                const int l = (ph == 15) ? 1 : 0; const float* cw = a.conv_w + (size_t)l * 3 * NUP; const float* cb = a.conv_b + (size_t)l * NUP;
                const bf16_t* ED = (const bf16_t*)(ws + WS_EDGE); bf16_t* ACTp = (bf16_t*)(ws + WS_ACT);
                pg8::Unit uu;
                for (int i = 0; S.next(i, uu); ++i) {
                    const int pm = uu.pm;
                    for (int q = tid; q < 2 * (DFF / 8); q += 512) { const int side = q >= DFF / 8 ? 1 : 0, jc = (q - side * (DFF / 8)) * 8; const int R = 256 * pm + (side ? 255 : 0);
                        const bool cut = side ? ((R & (SEQ - 1)) == SEQ - 1) : ((R & (SEQ - 1)) == 0);
                        const bf16_t* ep = side ? ED + ((size_t)pm * 4 + 2) * NUP : ED + ((size_t)(cut ? pm : pm - 1) * 4 + 3) * NUP;
                        const bf16_t* ec = ED + ((size_t)pm * 4 + (side ? 3 : 0)) * NUP;
                        const bf16_t* en = side ? ED + ((size_t)(cut ? pm : pm + 1) * 4 + 0) * NUP : ED + ((size_t)pm * 4 + 1) * NUP;
                        u32x4 wp[2], wc_[2], wn[2]; f32x4 k0[2][2], k1[2][2], k2[2][2], kb[2][2];
#pragma unroll
                        for (int h = 0; h < 2; ++h) { const int c = h * DFF + jc;
                            wp[h] = *(const u32x4*)(ep + c); wc_[h] = *(const u32x4*)(ec + c); wn[h] = *(const u32x4*)(en + c);
#pragma unroll
                            for (int v = 0; v < 2; ++v) { k0[h][v] = *(const f32x4*)(cw + c + 4 * v); k1[h][v] = *(const f32x4*)(cw + NUP + c + 4 * v); k2[h][v] = *(const f32x4*)(cw + 2 * NUP + c + 4 * v); kb[h][v] = *(const f32x4*)(cb + c + 4 * v); } }
                        float uv[2][8];
#pragma unroll
                        for (int h = 0; h < 2; ++h) { const unsigned pw[4] = {wp[h].x, wp[h].y, wp[h].z, wp[h].w}, cw_[4] = {wc_[h].x, wc_[h].y, wc_[h].z, wc_[h].w}, nw[4] = {wn[h].x, wn[h].y, wn[h].z, wn[h].w};
#pragma unroll
                            for (int e = 0; e < 8; ++e) { float vp = (e & 1) ? bf_hi(pw[e >> 1]) : bf_lo(pw[e >> 1]), vc = (e & 1) ? bf_hi(cw_[e >> 1]) : bf_lo(cw_[e >> 1]), vn = (e & 1) ? bf_hi(nw[e >> 1]) : bf_lo(nw[e >> 1]);
                                if (cut) { if (side) vn = 0.f; else vp = 0.f; }
                                uv[h][e] = k0[h][e >> 2][e & 3] * vp + k1[h][e >> 2][e & 3] * vc + k2[h][e >> 2][e & 3] * vn + kb[h][e >> 2][e & 3]; } }
                        float av[8];
#pragma unroll
                        for (int e = 0; e < 8; ++e) { const float sg = __builtin_amdgcn_rcpf(1.0f + __builtin_amdgcn_exp2f(-1.4426950408889634f * uv[0][e])); av[e] = uv[0][e] * sg * uv[1][e]; }
                        u32x4 o; o.x = cvt_pk_bf16(av[0], av[1]); o.y = cvt_pk_bf16(av[2], av[3]); o.z = cvt_pk_bf16(av[4], av[5]); o.w = cvt_pk_bf16(av[6], av[7]);
                        *(u32x4*)(ACTp + (size_t)R * DFF + jc) = o; }
                }
                asm volatile("s_waitcnt vmcnt(0)" ::: "memory"); __syncthreads();
            }
#endif
            pg8::EpiBf16 E{O, ldc};
            pg8::gemm_phase<pg8::EpiBf16, pg8::StaticOrder, false, true>(lds, g, S, E, tid);
#if HERM
            if (ph == 12) {
                const float* XNY = (const float*)(ws + WS_YNY) + 2048; float* YNY = (float*)(ws + WS_YNY); const bf16_t* WC = (const bf16_t*)(ws + WS_WC);
                for (int o = gw; o < NB * 1024; o += NGW) { const int b = o >> 10, n = o & 1023;
                    const f32x4* xp = (const f32x4*)(XNY + b * 1024 + lane * 16); const u32x4* wp = (const u32x4*)(WC + (size_t)n * 1024 + lane * 16);
                    const f32x4 x0 = xp[0], x1 = xp[1], x2 = xp[2], x3 = xp[3]; const u32x4 w0 = wp[0], w1 = wp[1];
                    float acc_ = x0[0] * bf_lo(w0.x) + x0[1] * bf_hi(w0.x) + x0[2] * bf_lo(w0.y) + x0[3] * bf_hi(w0.y) + x1[0] * bf_lo(w0.z) + x1[1] * bf_hi(w0.z) + x1[2] * bf_lo(w0.w) + x1[3] * bf_hi(w0.w)
                               + x2[0] * bf_lo(w1.x) + x2[1] * bf_hi(w1.x) + x2[2] * bf_lo(w1.y) + x2[3] * bf_hi(w1.y) + x3[0] * bf_lo(w1.z) + x3[1] * bf_hi(w1.z) + x3[2] * bf_lo(w1.w) + x3[3] * bf_hi(w1.w);
#pragma unroll
                    for (int o_ = 1; o_ < 64; o_ <<= 1) acc_ += __shfl_xor(acc_, o_);
                    if (lane == 0) YNY[b * 1024 + n] = acc_; }
            }
#endif
#endif
        } else if (kinds == 3) {
        } else if (kinds == 4) { PHASE_PRELUDE
#if PH & 16
#if ATT_FIXMAX
            float sbound; bool usefix;
            { float mq = fmaxf(fabsf(a.q_g[lane]), fabsf(a.q_g[64 + lane])), mk = fmaxf(fabsf(a.k_g[lane]), fabsf(a.k_g[64 + lane]));
#pragma unroll
              for (int o_ = 1; o_ < 64; o_ <<= 1) { mq = fmaxf(mq, __shfl_xor(mq, o_)); mk = fmaxf(mk, __shfl_xor(mk, o_)); }
              sbound = 11.313708499f * mq * mk * 1.03f + 0.05f; usefix = sbound < 30.0f; }
#endif
#define GLOBAL_UNITS(CALL) for (int u = vcu; u < 512; u += G) { const int b = u >> 8, h = (u >> 6) & 3, qb = u & 63; \
                bf16_t* Qp = (bf16_t*)(ws + WS_Q) + ((size_t)(b * SEQ + qb * 256)) * DM + h * HD; \
                const bf16_t* Kp = (const bf16_t*)(ws + WS_KA) + (size_t)(b * 2 + (h >> 1)) * SKV * HD; const bf16_t* Vp = Kp + KV_BYTES / 2; \
                bf16_t* Op = (bf16_t*)(ws + WS_O) + (Qp - (bf16_t*)(ws + WS_Q)); CALL; }
#if ATT_FIXMAX
            if (usefix) { GLOBAL_UNITS((att::attn_unit<false, true>(Qp, Kp, Vp, Op, SKV / 64, 0, 0, sbound, 0.f, (char*)ldsraw, tid))); }
            else
#endif
            { GLOBAL_UNITS((att::attn_unit<false, false>(Qp, Kp, Vp, Op, SKV / 64, 0, 0, -1e30f, 0.f, (char*)ldsraw, tid))); }
#undef GLOBAL_UNITS
#endif
#if PH & 32
            for (int u = vcu; u < 512; u += G) {
                const int b = u >> 8, h = (u >> 6) & 3, qb = u & 63;
                bf16_t* Qp = (bf16_t*)(ws + WS_Q) + ((size_t)(b * SEQ + qb * 256)) * DM + 512 + h * HD;
                const bf16_t* Kp = (const bf16_t*)(ws + WS_KB) + (size_t)(b * 2 + (h >> 1)) * SKV * HD; const bf16_t* Vp = Kp + KV_BYTES / 2;
                const int q0 = qb * 256; const int lo_tok = (q0 == 0) ? 0 : q0 - 128; const int nloc = (q0 == 0 || q0 == SEQ - 256) ? 6 : 8;
                att::attn_unit<true>(Qp, Kp, Vp, (bf16_t*)(ws + WS_O) + (Qp - (bf16_t*)(ws + WS_Q)), 4 + nloc, CTXL + lo_tok, lo_tok - q0, a.sink[h] / att::SCALE, 1.f, (char*)ldsraw, tid);
            }
#endif
        } else if (kinds == 5) { PHASE_PRELUDE
#if PH & 64
            const int l = (ph >= 13) ? 1 : 0, which = (ph == 9 || ph == 16) ? 1 : 0;
            residual_phase(a, l, which, gw, NGW, lane);
#endif
        } else if (kinds == 6) { PHASE_PRELUDE
#if PH & 512
            const int l = (ph == 14) ? 1 : 0;
#if CONV_ALIGNED
            pg8::Gemm g{XN, (const bf16_t*)(ws + (l ? WS_WUP1 : WS_WUP0)), 1024, 256}; pg8::StaticOrder S; S.init(MTOK / 256, NUP / 256, G, bx);
#else
            pg8::Gemm g{XN - DM, (const bf16_t*)(ws + (l ? WS_WUP1 : WS_WUP0)), 1024, 254}; pg8::StaticOrder S; S.init(NTILE_UP, NUP / 256, G, bx);
#endif
            pg8::EpiConvGate E{(bf16_t*)(ws + WS_ACT), a.conv_w + (size_t)l * 3 * NUP, a.conv_b + (size_t)l * NUP, lds + LDS_XCH, (bf16_t*)(ws + WS_EDGE)};
            pg8::gemm_phase<pg8::EpiConvGate, pg8::StaticOrder, true, true>(lds, g, S, E, tid);
#endif
        } else if (kinds == 7) { PHASE_PRELUDE
#if PH & 128
            att::dft_phase<1>(XN, nullptr, (bf16_t*)(ws + WS_Y1R), (bf16_t*)(ws + WS_Y1I), (const f32x2*)(ws + WS_TW), (const bf16x8*)(ws + WS_DFTW), vcu, G, (char*)ldsraw, tid);
#endif
        } else { PHASE_PRELUDE
#if PH & 256
#if HERM
            {
                LAS float* red = (LAS float*)(lds + LDS_XCH); float* XNY = (float*)(ws + WS_YNY) + 2048; const bf16_t* Y1R = (const bf16_t*)(ws + WS_Y1R);
                for (int item = vcu; item < NB * 128; item += G) { const int b = item >> 7, cg8 = (item & 127) * 8; const int n2 = tid >> 2, cp = tid & 3;
                    const unsigned e = *(const unsigned*)(Y1R + ((size_t)b * SEQ + n2) * DM + cg8 + 2 * cp); const float sg = (n2 & 1) ? -1.0f : 1.0f;
                    red[(n2 * 4 + cp) * 2] = sg * bf_lo(e); red[(n2 * 4 + cp) * 2 + 1] = sg * bf_hi(e);
                    __syncthreads();
                    if (tid < 8) { float s_ = 0.f; for (int r = 0; r < 128; ++r) s_ += red[r * 8 + tid]; XNY[b * 1024 + cg8 + tid] = s_; }
                    __syncthreads(); }
            }
#endif
            att::dft_phase<2>((const bf16_t*)(ws + WS_Y1R), (const bf16_t*)(ws + WS_Y1I), (bf16_t*)(ws + (HERM ? WS_XR : WS_A2)), (bf16_t*)(ws + WS_XI), nullptr, (const bf16x8*)(ws + WS_DFTW), vcu, G, (char*)ldsraw, tid);
#endif
        }
        if (kinds == 3) { PHASE_PRELUDE
#if PH & 8
            if (CTX_IN_P3) {
                if (bx < 8) { asm volatile("s_waitcnt vmcnt(0)" ::: "memory"); __syncthreads();
                    ctx_tile_post(a, bx >> 2, 4 + (bx & 3), wave, lane); }
                else qkv_post(a, 0, MTOK, (bx - 8) * 8 + wave, (G - 8) * 8, lane, -1, -1);
            } else qkv_post(a, 0, MALL, gw, NGW, lane, -1, -1);
#endif
        }
        }
#ifdef DBG_STOP
        if (ph == DBG_STOP) { PHASE_PRELUDE
            asm volatile("s_waitcnt vmcnt(0)" ::: "memory"); __syncthreads();
            if (wave_s == 0) { __builtin_amdgcn_fence(__ATOMIC_RELEASE, "agent"); asm volatile("s_waitcnt vmcnt(0)" ::: "memory"); }
            grid.sync();
            __builtin_amdgcn_fence(__ATOMIC_ACQUIRE, "agent"); asm volatile("s_waitcnt vmcnt(0)" ::: "memory");
            const bf16_t* buf = (const bf16_t*)(ws + DBG_BUF); const int ld = DBG_LD;
            for (size_t i = (size_t)bx * 512 + tid; i < (size_t)MTOK * DM; i += (size_t)G * 512) { const size_t r = i >> 10; const int c = (int)(i & 1023); float acc = 0.f;
                for (int j = 0; c + 1024 * j < ld; ++j) acc += bf_lo((unsigned)buf[r * ld + c + 1024 * j]);
#ifdef DBG_ADD_OUT
                acc += a.out[i];
#endif
                a.out[i] = acc; }
            return;
        }
#endif
#ifdef EXTRA_SEAMS
        if (ph == 5) { for (int es = 0; es < EXTRA_SEAMS; ++es) GRID_SEAM(); }
#endif
        if (gridDim.x > 0x40000000u) grid.sync();
        if (ph + 1 < NPH) {
            GRID_SEAM();
        }
    }
}

extern "C" void kernel_launch(void* const* d_in, const int* in_sizes, int n_in, void* d_out, int out_size, void* d_ws, size_t ws_size, hipStream_t stream) {
    static int grid = 0;
    if (grid == 0) {
        if (n_in != 17 || in_sizes[0] != MTOK * DM || out_size != MTOK * DM || ws_size < WS_END) { fprintf(stderr, "kernel_launch: unexpected shapes (n_in %d, in0 %d, out %d, ws %zu)\n", n_in, n_in > 0 ? in_sizes[0] : -1, out_size, ws_size); grid = -1; return; }
        int dev = 0, cus = 0, per_cu = 0;
        hipGetDevice(&dev); hipDeviceGetAttribute(&cus, hipDeviceAttributeMultiprocessorCount, dev);
        if (hipFuncSetAttribute((const void*)fwd_megakernel, hipFuncAttributeMaxDynamicSharedMemorySize, LDS_BYTES) != hipSuccess) { fprintf(stderr, "kernel_launch: hipFuncSetAttribute failed\n"); grid = -1; return; }
        if (hipOccupancyMaxActiveBlocksPerMultiprocessor(&per_cu, (const void*)fwd_megakernel, 512, LDS_BYTES) != hipSuccess || per_cu < 1) { fprintf(stderr, "kernel_launch: occupancy query gave %d\n", per_cu); per_cu = 1; }
        (void)hipGetLastError();
        grid = cus;
    }
    if (grid < 0) return;
    Args a{};
    a.x = (const float*)d_in[0]; a.c = (const float*)d_in[1]; a.ctx = (const float*)d_in[2]; a.c_ctx = (const float*)d_in[3]; a.mod_w = (const float*)d_in[4]; a.mod_b = (const float*)d_in[5];
    a.norm_g = (const float*)d_in[6]; a.w_in = (const float*)d_in[7]; a.w_out = (const float*)d_in[8]; a.q_g = (const float*)d_in[9]; a.k_g = (const float*)d_in[10]; a.sink = (const float*)d_in[11];
    a.w_f = (const float*)d_in[12]; a.w_up = (const float*)d_in[13]; a.conv_w = (const float*)d_in[14]; a.conv_b = (const float*)d_in[15]; a.w_down = (const float*)d_in[16];
    a.out = (float*)d_out; a.ws = (unsigned char*)d_ws;
    if (hipMemsetAsync((char*)d_ws + WS_CTL, 0, 16384, stream) != hipSuccess) { fprintf(stderr, "kernel_launch: hipMemsetAsync failed\n"); return; }
    void* args[] = {&a};
    hipError_t e = hipLaunchCooperativeKernel((const void*)fwd_megakernel, dim3(grid), dim3(512), args, LDS_BYTES, stream);
    if (e != hipSuccess) fprintf(stderr, "kernel_launch: cooperative launch failed: %s (grid %d)\n", hipGetErrorString(e), grid);
}
```

```cpp
#include <hip/hip_runtime.h>
#include <hip/hip_cooperative_groups.h>
#include <cstdio>
#include <cstdint>
namespace cg = cooperative_groups;
#ifndef CONV_ALIGNED
#define CONV_ALIGNED 1
#endif
#ifndef ATT_FIXMAX
#define ATT_FIXMAX 1
#endif
#ifndef CTX_IN_P3
#define CTX_IN_P3 1
#endif
#ifndef HERM
#define HERM 1
#endif
#ifndef RES_ROWS
#define RES_ROWS 2
#endif
#ifndef FUSE_QKV
#define FUSE_QKV 0
#endif

constexpr int DM = 1024, NB = 2, SEQ = 16384, CTXL = 256, HD = 128;
constexpr int MTOK = NB * SEQ;
constexpr int MALL = MTOK + NB * CTXL;
constexpr int DFF = 2816, NUP = 2 * DFF;
constexpr int SKV = CTXL + SEQ;
constexpr int NPROJ = 2048;
constexpr float EPS = 1e-6f;
constexpr int NTILE_UP = 130;
constexpr size_t MiB = 1u << 20;
constexpr size_t WS_MOD = 0;
constexpr size_t WS_ROPE = 256 * 1024;
constexpr size_t WS_TW = 512 * 1024;
constexpr size_t WS_DFTW = 768 * 1024;
constexpr size_t WS_CTL = 896 * 1024;
constexpr size_t WS_WIN = 1 * MiB, WS_WOUT = 5 * MiB, WS_WP = 7 * MiB, WS_WUP0 = 11 * MiB, WS_WUP1 = 22 * MiB, WS_WDN0 = 33 * MiB, WS_WDN1 = 39 * MiB;
constexpr size_t WS_XN = 46 * MiB + 4096;
constexpr size_t WS_Y = 112 * MiB;
constexpr size_t WS_BIG = 176 * MiB;
constexpr size_t WS_PROJ = WS_BIG;
constexpr size_t WS_Q = WS_BIG + 130 * MiB;
constexpr size_t KV_BYTES = (size_t)NB * 2 * SKV * HD * 2;
constexpr size_t WS_KA = WS_Q + 64 * MiB, WS_VA = WS_KA + KV_BYTES, WS_KB = WS_VA + KV_BYTES, WS_VB = WS_KB + KV_BYTES;
constexpr size_t WS_O = WS_BIG;
constexpr size_t WS_ACT = WS_BIG;
constexpr size_t WS_Y1R = WS_BIG, WS_Y1I = WS_BIG + 64 * MiB;
constexpr size_t WS_A2 = WS_BIG + 128 * MiB;
constexpr size_t WS_XRES = 440 * MiB;
constexpr size_t WS_EDGE = 504 * MiB;
constexpr size_t WS_WC = WS_WP, WS_WS = WS_WP + 2 * MiB;
constexpr size_t WS_XR = WS_A2, WS_XI = WS_A2 + 32 * MiB;
constexpr size_t WS_YNY = 192 * 1024;
constexpr size_t WS_END = WS_EDGE + (size_t)128 * 4 * NUP * 2;
static_assert(WS_END <= 512 * MiB && WS_A2 + (size_t)MTOK * 2048 * 2 <= WS_XRES && WS_VB + KV_BYTES <= WS_XRES, "ws map");
constexpr int LDS_XCH = 131072;
constexpr int LDS_MISC = 139264;
constexpr int LDS_BYTES = 147456;

typedef unsigned short bf16_t;
typedef short bf16x8 __attribute__((ext_vector_type(8)));
typedef short s16x4 __attribute__((ext_vector_type(4)));
typedef float f32x4 __attribute__((ext_vector_type(4)));
typedef float f32x2 __attribute__((ext_vector_type(2)));
typedef float f32x16 __attribute__((ext_vector_type(16)));
typedef unsigned u32x4 __attribute__((ext_vector_type(4)));
typedef unsigned u32x2 __attribute__((ext_vector_type(2)));
#define LAS __attribute__((address_space(3)))

typedef __bf16 bf16x2_t __attribute__((ext_vector_type(2)));
__device__ __forceinline__ unsigned cvt_pk_bf16(float lo, float hi) { f32x2 v = {lo, hi}; bf16x2_t b = __builtin_convertvector(v, bf16x2_t); return __builtin_bit_cast(unsigned, b); }
__device__ __forceinline__ float bf_lo(unsigned w) { return __uint_as_float(w << 16); }
__device__ __forceinline__ float bf_hi(unsigned w) { return __uint_as_float(w & 0xffff0000u); }
__device__ __forceinline__ bf16_t f2bf(float f) { return (bf16_t)(cvt_pk_bf16(f, 0.f) & 0xffffu); }
__device__ __forceinline__ float wave_sum(float v) {
#pragma unroll
    for (int o = 1; o < 64; o <<= 1) v += __shfl_xor(v, o);
    return v;
}

namespace pg8 {
#define PG8_LAS __attribute__((address_space(3)))
typedef unsigned short bf16_t;
typedef short bf16x8 __attribute__((ext_vector_type(8)));
typedef float f32x4 __attribute__((ext_vector_type(4)));
typedef unsigned u32x4 __attribute__((ext_vector_type(4)));
constexpr int BM = 256, BK = 64, HALF = 128, HTB = HALF * BK * 2  , STAGE_BYTES = 8 * HTB, NXCD = 8, WGM = 8;

__host__ __device__ __forceinline__ int lds_byte(int r, int c) { const int st = (r >> 4) * 2 + (c >> 5), rr = r & 15, cc = c & 31, ob = rr * 64 + cc * 2; return st * 1024 + (ob ^ (((ob >> 9) & 1) << 5)); }
__host__ __device__ __forceinline__ void stage_rc(int b, int& R, int& C) { const int st = b / 1024, sb = b % 1024, swz = sb ^ (((sb >> 9) & 1) << 5); R = (st >> 1) * 16 + swz / 64; C = (st & 1) * 32 + (swz % 64) / 2; }
__host__ __device__ __forceinline__ int perm32(int rho) { const int n = rho >> 4, i = rho & 15; return 8 * (i >> 2) + 4 * n + (i & 3); }

struct Unit { int pm, pn; };
struct Gemm { const bf16_t* A; const bf16_t* Bt; int K; int a_rows; int msplit = 1 << 30; size_t bsplit = 0; };

struct StaticOrder {
    int nM, nN, nwg, G, c; int fpm = -1, fpn = 0;
    __host__ __device__ void init(int nM_, int nN_, int G_, int c_) { nM = nM_; nN = nN_; nwg = nM * nN; G = G_; c = c_; }
    __host__ __device__ bool next(int i, Unit& u) const {
        if (fpm >= 0) { if (i) return false; u.pm = fpm; u.pn = fpn; return true; }
        const long L = (long)i * G + c; if (L >= nwg) return false;
        int wgid = (int)L; { const int q = nwg / NXCD, r = nwg % NXCD, xcd = wgid % NXCD, off = wgid / NXCD; wgid = (xcd < r ? xcd * (q + 1) : r * (q + 1) + (xcd - r) * q) + off; }
        const int nig = WGM * nN, gid = wgid / nig, fm = gid * WGM, gsz = (nM - fm) < WGM ? (nM - fm) : WGM;
        u.pm = fm + ((wgid % nig) % gsz); u.pn = (wgid % nig) / gsz; return true;
    }
    __device__ __forceinline__ void a_ready(const Unit&) const {}
    __device__ __forceinline__ void done(const Unit&) const {}
};

struct EpiBf16 {
    static constexpr bool PERM = true, AFTER_DRAIN = false;
    bf16_t* O; int ldc;
    __device__ __forceinline__ void operator()(const f32x4 (&acc)[2][2][4][2], const Unit& u, int wr, int wc, int fr, int fq) const {
        const int row0 = u.pm * BM + wr * 64 + fr; const int col0 = u.pn * BM + wc * 32 + 8 * fq;
#pragma unroll
        for (int ai = 0; ai < 2; ++ai)
#pragma unroll
            for (int m = 0; m < 4; ++m) { bf16_t* rowp = O + (size_t)(row0 + ai * HALF + m * 16) * ldc + col0;
#pragma unroll
                for (int bj = 0; bj < 2; ++bj) { const f32x4 v0 = acc[ai][bj][m][0], v1 = acc[ai][bj][m][1];
                    u32x4 w; w.x = cvt_pk_bf16(v0[0], v0[1]); w.y = cvt_pk_bf16(v0[2], v0[3]); w.z = cvt_pk_bf16(v1[0], v1[1]); w.w = cvt_pk_bf16(v1[2], v1[3]);
                    *(u32x4*)(rowp + bj * HALF) = w; } }
    }
};

struct EpiQKV {
    static constexpr bool PERM = true, AFTER_DRAIN = false;
    bf16_t* Q; bf16_t* KV; const float* qg; const float* kg; const f32x2* rope; PG8_LAS unsigned char* xch;
    __device__ __forceinline__ void operator()(const f32x4 (&acc)[2][2][4][2], const Unit& u, int wr, int wc, int fr_in, int fq_in) const {
        int fr = fr_in, fq = fq_in; asm volatile("" : "+v"(fr), "+v"(fq));
        const int pn = u.pn, pm = u.pm;
        const bool isctx = pm >= MTOK / 256, donorm = (pn < 2) || (pn == 4), dorope = !isctx && (pn < 5 || pn == 6);
        if (isctx && pn < 4) return;
        PG8_LAS float* P = (PG8_LAS float*)xch;
        if (donorm) {
#pragma unroll
            for (int ai = 0; ai < 2; ++ai)
#pragma unroll
                for (int m = 0; m < 4; ++m)
#pragma unroll
                    for (int bj = 0; bj < 2; ++bj) { const f32x4 v0 = acc[ai][bj][m][0], v1 = acc[ai][bj][m][1];
                        float ss = (v0[0] * v0[0] + v0[1] * v0[1]) + (v0[2] * v0[2] + v0[3] * v0[3]) + (v1[0] * v1[0] + v1[1] * v1[1]) + (v1[2] * v1[2] + v1[3] * v1[3]);
                        ss += __shfl_xor(ss, 16); ss += __shfl_xor(ss, 32);
                        if (fq == 0) P[((128 * ai + 64 * wr + 16 * m + fr) * 2 + bj) * 4 + wc] = ss; }
            asm volatile("s_waitcnt lgkmcnt(0)" ::: "memory"); __builtin_amdgcn_s_barrier(); asm volatile("" ::: "memory");
        }
        const int ax = wc >> 1, f0 = 16 * (wc & 1) + 4 * fq, dl = 64 * ax + f0;
        f32x4 g1 = {1.f, 1.f, 1.f, 1.f}, g2 = {1.f, 1.f, 1.f, 1.f};
        if (donorm) { const float* gp = (pn == 4) ? kg : qg; g1 = *(const f32x4*)(gp + dl); g2 = *(const f32x4*)(gp + dl + 32); }
        const int col0 = wc * 32 + 8 * fq;
#pragma unroll
        for (int ai = 0; ai < 2; ++ai)
#pragma unroll
            for (int m = 0; m < 4; ++m) {
                const int rl = 128 * ai + 64 * wr + 16 * m + fr, grow = 256 * pm + rl;
                const int b = isctx ? ((grow - MTOK) >> 8) : (grow >> 14), t = isctx ? ((grow - MTOK) & 255) : (grow & (SEQ - 1));
                f32x4 cA = {1.f, 0.f, 1.f, 0.f}, cB = {1.f, 0.f, 1.f, 0.f};
                if (dorope) { const int pos = ax ? (t & 63) : (t >> 6); const f32x4* rp = (const f32x4*)(rope + pos * 32 + f0); cA = rp[0]; cB = rp[1]; }
                const f32x4 cs = {cA[0], cA[2], cB[0], cB[2]}, sn = {cA[1], cA[3], cB[1], cB[3]};
#pragma unroll
                for (int bj = 0; bj < 2; ++bj) {
                    f32x4 x1 = acc[ai][bj][m][0], x2 = acc[ai][bj][m][1];
                    if (donorm) { const f32x4 pp = *(const PG8_LAS f32x4*)(P + (rl * 2 + bj) * 4); const float r = rsqrtf(((pp[0] + pp[1]) + (pp[2] + pp[3])) * (1.0f / 128.0f) + EPS);
                        x1 = x1 * r * g1; x2 = x2 * r * g2; }
                    const f32x4 o1 = x1 * cs - x2 * sn, o2 = x2 * cs + x1 * sn;
                    u32x4 w; w.x = cvt_pk_bf16(o1[0], o1[1]); w.y = cvt_pk_bf16(o1[2], o1[3]); w.z = cvt_pk_bf16(o2[0], o2[1]); w.w = cvt_pk_bf16(o2[2], o2[3]);
                    bf16_t* dst = (pn < 4) ? Q + (size_t)grow * DM + pn * 256 + bj * 128 + col0
                                           : KV + (size_t)(pn - 4) * (KV_BYTES / 2) + ((size_t)(b * 2 + bj) * SKV + (isctx ? t : CTXL + t)) * HD + col0;
                    *(u32x4*)dst = w;
                }
            }
    }
};

__device__ __forceinline__ float dpp_shr1(float old, float src) { return __builtin_bit_cast(float, __builtin_amdgcn_update_dpp(__builtin_bit_cast(int, old), __builtin_bit_cast(int, src), 0x111, 0xf, 0xf, false)); }
__device__ __forceinline__ float dpp_shl1(float old, float src) { return __builtin_bit_cast(float, __builtin_amdgcn_update_dpp(__builtin_bit_cast(int, old), __builtin_bit_cast(int, src), 0x101, 0xf, 0xf, false)); }
__device__ __forceinline__ float dpp_ror1(float src) { return __builtin_bit_cast(float, __builtin_amdgcn_update_dpp(0, __builtin_bit_cast(int, src), 0x121, 0xf, 0xf, false)); }
__device__ __forceinline__ float dpp_rol1(float src) { return __builtin_bit_cast(float, __builtin_amdgcn_update_dpp(0, __builtin_bit_cast(int, src), 0x12F, 0xf, 0xf, false)); }

struct EpiConvGate {
    static constexpr bool PERM = false, AFTER_DRAIN = false;
    bf16_t* ACT; const float* cw; const float* cb; PG8_LAS unsigned char* xch; bf16_t* EDGE;
    __device__ __forceinline__ void operator()(const f32x4 (&acc)[2][2][4][2], const Unit& u, int wr, int wc, int fr_in, int fq_in) const {
        int fr = fr_in, fq = fq_in; asm volatile("" : "+v"(fr), "+v"(fq));
        PG8_LAS f32x4* XF = (PG8_LAS f32x4*)xch; PG8_LAS f32x4* XL = XF + 256;
#pragma unroll
        for (int ai = 0; ai < 2; ++ai) { const int idx = (((2 * ai + wr) * 4 + wc) * 4 + fq) * 4;
            if (fr == 0) {
#pragma unroll
                for (int bj = 0; bj < 2; ++bj)
#pragma unroll
                    for (int n = 0; n < 2; ++n) XF[idx + bj * 2 + n] = acc[ai][bj][0][n]; }
            if (fr == 15) {
#pragma unroll
                for (int bj = 0; bj < 2; ++bj)
#pragma unroll
                    for (int n = 0; n < 2; ++n) XL[idx + bj * 2 + n] = acc[ai][bj][3][n]; } }
        asm volatile("s_waitcnt lgkmcnt(0)" ::: "memory"); __builtin_amdgcn_s_barrier(); asm volatile("" ::: "memory");
        const int jcol = u.pn * 128 + wc * 32 + 4 * fq;
#if CONV_ALIGNED
        if ((wr == 0 && fr < 2) || (wr == 1 && fr >= 14)) { const int slot = (wr == 0) ? fr : fr - 12;
#pragma unroll
            for (int bj = 0; bj < 2; ++bj)
#pragma unroll
                for (int n = 0; n < 2; ++n) { const f32x4 v = (wr == 0) ? acc[0][bj][0][n] : acc[1][bj][3][n]; u32x2 w; w.x = cvt_pk_bf16(v[0], v[1]); w.y = cvt_pk_bf16(v[2], v[3]);
                    *(u32x2*)(EDGE + ((size_t)u.pm * 4 + slot) * NUP + bj * DFF + jcol + 16 * n) = w; } }
#endif
        const int Tlo = 254 * u.pm - 1; const bool edge = ((Tlo + 1) & (SEQ - 1)) > ((Tlo + 256) & (SEQ - 1)) || ((Tlo + 1) & (SEQ - 1)) == 0;
#pragma unroll
        for (int n = 0; n < 2; ++n) {
            f32x4 w0[2], w1[2], w2[2], bb[2];
            __attribute__((address_space(1))) bf16_t* sp = (__attribute__((address_space(1))) bf16_t*)ACT + (long)((CONV_ALIGNED ? 256 * u.pm : 254 * u.pm - 1) + 64 * wr + fr) * DFF + jcol + 16 * n;
#pragma unroll
            for (int bj = 0; bj < 2; ++bj) { const int col = bj * DFF + jcol + 16 * n;
                w0[bj] = *(const f32x4*)(cw + col); w1[bj] = *(const f32x4*)(cw + NUP + col); w2[bj] = *(const f32x4*)(cw + 2 * NUP + col); bb[bj] = *(const f32x4*)(cb + col); }
#pragma unroll
            for (int ai = 0; ai < 2; ++ai) {
                const int G = 2 * ai + wr;
                f32x4 hp[2], hn[2];
#pragma unroll
                for (int bj = 0; bj < 2; ++bj) { hp[bj] = XL[((((G + 3) & 3) * 4 + wc) * 4 + fq) * 4 + bj * 2 + n]; hn[bj] = XF[((((G + 1) & 3) * 4 + wc) * 4 + fq) * 4 + bj * 2 + n]; }
#pragma unroll
                for (int m = 0; m < 4; ++m) {
                    const int rl = 128 * ai + 64 * wr + 16 * m + fr; const int T = (CONV_ALIGNED ? 256 * u.pm : 254 * u.pm - 1) + rl; const int tin = T & (SEQ - 1);
                    const bool first = (tin == 0), last = (tin == SEQ - 1), valid = (rl >= 1) && (rl <= 254) && (T < MTOK);
                    f32x4 uu[2];
#pragma unroll
                    for (int bj = 0; bj < 2; ++bj) {
                        const f32x4 cur = acc[ai][bj][m][n]; f32x4 prv, nxt;
#pragma unroll
                        for (int i = 0; i < 4; ++i) {
                            const float op = (m == 0) ? hp[bj][i] : dpp_ror1(acc[ai][bj][m == 0 ? 0 : m - 1][n][i]);
                            const float on = (m == 3) ? hn[bj][i] : dpp_rol1(acc[ai][bj][m == 3 ? 3 : m + 1][n][i]);
                            prv[i] = dpp_shr1(op, cur[i]); nxt[i] = dpp_shl1(on, cur[i]); }
                        if (!CONV_ALIGNED && edge) { if (first) prv = (f32x4){0.f, 0.f, 0.f, 0.f}; if (last) nxt = (f32x4){0.f, 0.f, 0.f, 0.f}; }
                        uu[bj] = w0[bj] * prv + w1[bj] * cur + w2[bj] * nxt + bb[bj];
                    }
                    float a[4];
#pragma unroll
                    for (int i = 0; i < 4; ++i) { const float gv = uu[0][i]; const float sg = __builtin_amdgcn_rcpf(1.0f + __builtin_amdgcn_exp2f(-1.4426950408889634f * gv)); a[i] = gv * sg * uu[1][i]; }
                    if (valid) { u32x2 w; w.x = cvt_pk_bf16(a[0], a[1]); w.y = cvt_pk_bf16(a[2], a[3]); *(__attribute__((address_space(1))) u32x2*)sp = w; }
                    sp += (m == 3 ? 80 : 16) * DFF; asm volatile("" : "+v"(sp));
                }
            }
        }
    }
};

template <class Epi, class Sched, bool ALIGN_EPI = false, bool SP2 = false>
__device__ __forceinline__ void gemm_phase(PG8_LAS unsigned char* lds, const Gemm g, const Sched& S, const Epi& E, int tid_in) {
    int tid_o = tid_in; asm volatile("" : "+v"(tid_o));
    const int tid = tid_o, wid = __builtin_amdgcn_readfirstlane(tid >> 6), lane = tid & 63, wr = wid >> 2, wc = wid & 3, fr = lane & 15, fq = lane >> 4;
    const int K = g.K, nt = K / BK;
    unsigned voffA[2], voffB[2];
#pragma unroll
    for (int i = 0; i < 2; ++i) { int R, C; stage_rc(tid * 16 + i * 8192, R, C); const int Rb = Epi::PERM ? ((R & ~31) + perm32(R & 31)) : R;
        voffA[i] = (unsigned)(R * K + C) * 2u; voffB[i] = (unsigned)(Rb * K + C) * 2u; }
    const size_t kstep = (size_t)(BK * 2);
    const size_t hstep = (size_t)HALF * K * 2;
    const size_t tstep = 2 * hstep; const size_t tstepA = (size_t)g.a_rows * K * 2;
    const unsigned ldsw = (unsigned)wid * 1024u;
    const int aoff = lds_byte(wr * 64 + fr, fq * 8), boff = lds_byte(wc * 32 + fr, fq * 8);
#define PG8_SA(b, h) (((b) * 2 + (h)) * HTB)
#define PG8_SB(b, h) ((4 + (b) * 2 + (h)) * HTB)
#define PG8_STAGE(bufoff, gbase, voff) do { _Pragma("unroll") for (int _i = 0; _i < 2; ++_i) \
        __builtin_amdgcn_global_load_lds((const unsigned*)((const char*)(gbase) + (voff)[_i]), (PG8_LAS unsigned*)(lds + (bufoff) + ldsw + _i * 8192), 16, 0, 0); } while (0)
#define PG8_LDA(dst, b, h) do { _Pragma("unroll") for (int m = 0; m < 4; ++m) _Pragma("unroll") for (int k = 0; k < 2; ++k) dst[m][k] = *(const PG8_LAS bf16x8*)(lds + PG8_SA(b, h) + aoff + m * 2048 + k * 1024); } while (0)
#define PG8_LDB(dst, b, h) do { _Pragma("unroll") for (int n = 0; n < 2; ++n) _Pragma("unroll") for (int k = 0; k < 2; ++k) dst[n][k] = *(const PG8_LAS bf16x8*)(lds + PG8_SB(b, h) + boff + n * 2048 + k * 1024); } while (0)
#define PG8_MMA(ai, bj, At, Bt) do { __builtin_amdgcn_s_setprio(1); _Pragma("unroll") for (int m = 0; m < 4; ++m) _Pragma("unroll") for (int n = 0; n < 2; ++n) _Pragma("unroll") for (int k = 0; k < 2; ++k) \
        acc[ai][bj][m][n] = __builtin_amdgcn_mfma_f32_16x16x32_bf16(Bt[n][k], At[m][k], acc[ai][bj][m][n], 0, 0, 0); __builtin_amdgcn_s_setprio(0); } while (0)
#define PG8_WAIT_V(n) asm volatile("s_waitcnt vmcnt(" #n ")" ::: "memory")
#define PG8_WAIT_L(n) asm volatile("s_waitcnt lgkmcnt(" #n ")" ::: "memory")
#define PG8_BAR __builtin_amdgcn_s_barrier()
#define PG8_SCHED __builtin_amdgcn_sched_barrier(0)
    Unit cur, nxt; int ui = 0;
    if (!S.next(0, cur)) return;
    f32x4 acc[2][2][4][2];
#pragma unroll
    for (int a = 0; a < 2; ++a)
#pragma unroll
        for (int b = 0; b < 2; ++b)
#pragma unroll
            for (int m = 0; m < 4; ++m)
#pragma unroll
                for (int n = 0; n < 2; ++n) acc[a][b][m][n] = (f32x4){0.f, 0.f, 0.f, 0.f};
    bf16x8 At[4][2], B0[2][2], B1[2][2];
    const char* cA = (const char*)g.A + (size_t)cur.pm * tstepA; const char* cB = (const char*)g.Bt + (size_t)cur.pn * tstep + (cur.pm >= g.msplit ? g.bsplit : (size_t)0);
    S.a_ready(cur);
    if constexpr (SP2) {
        PG8_STAGE(PG8_SB(0, 0), cB, voffB); PG8_STAGE(PG8_SB(0, 1), cB + hstep, voffB); PG8_STAGE(PG8_SA(0, 0), cA, voffA); PG8_STAGE(PG8_SA(0, 1), cA + hstep, voffA);
        if (wr == 1) PG8_BAR;
        PG8_WAIT_V(2); PG8_BAR;
        PG8_STAGE(PG8_SB(1, 0), cB + kstep, voffB); PG8_STAGE(PG8_SA(1, 0), cA + kstep, voffA); PG8_STAGE(PG8_SB(1, 1), cB + hstep + kstep, voffB);
        PG8_WAIT_V(6); PG8_BAR;
    } else {
        PG8_STAGE(PG8_SB(0, 0), cB, voffB); PG8_STAGE(PG8_SA(0, 0), cA, voffA); PG8_STAGE(PG8_SB(0, 1), cB + hstep, voffB); PG8_STAGE(PG8_SA(0, 1), cA + hstep, voffA);
        if (wr == 1) PG8_BAR;
        PG8_WAIT_V(4); PG8_BAR;
        PG8_STAGE(PG8_SB(1, 0), cB + kstep, voffB); PG8_STAGE(PG8_SA(1, 0), cA + kstep, voffA); PG8_STAGE(PG8_SB(1, 1), cB + hstep + kstep, voffB);
        PG8_WAIT_V(6); PG8_BAR;
    }
    for (;;) {
        const bool has_next = S.next(ui + 1, nxt);
        const char* nA = has_next ? (const char*)g.A + (size_t)nxt.pm * tstepA : cA; const char* nB = has_next ? (const char*)g.Bt + (size_t)nxt.pn * tstep + (nxt.pm >= g.msplit ? g.bsplit : (size_t)0) : cB;
        for (int t = 0; t < nt; t += 2) {
            const bool last = (t == nt - 2);
            const char* a1 = cA + (size_t)(t + 1) * kstep;
            const char* a2 = last ? nA : cA + (size_t)(t + 2) * kstep; const char* b2 = last ? nB : cB + (size_t)(t + 2) * kstep;
            const char* a3 = a2 + kstep; const char* b3 = b2 + kstep;
            if (last && has_next) S.a_ready(nxt);
            if constexpr (SP2) {
            PG8_LDB(B0, 0, 0); PG8_LDB(B1, 0, 1); PG8_SCHED; PG8_LDA(At, 0, 0); PG8_STAGE(PG8_SA(1, 1), a1 + hstep, voffA);
            PG8_WAIT_V(8); PG8_WAIT_L(0); PG8_BAR; PG8_MMA(0, 0, At, B0); PG8_MMA(0, 1, At, B1); PG8_BAR; PG8_SCHED;
            PG8_LDA(At, 0, 1); PG8_STAGE(PG8_SB(0, 0), b2, voffB); PG8_STAGE(PG8_SB(0, 1), b2 + hstep, voffB); PG8_STAGE(PG8_SA(0, 0), a2, voffA);
            PG8_WAIT_V(8); PG8_WAIT_L(0); PG8_BAR; PG8_MMA(1, 0, At, B0); PG8_MMA(1, 1, At, B1); PG8_BAR; PG8_SCHED;
            PG8_LDB(B0, 1, 0); PG8_LDB(B1, 1, 1); PG8_SCHED; PG8_LDA(At, 1, 0); PG8_STAGE(PG8_SA(0, 1), a2 + hstep, voffA);
            PG8_WAIT_V(8); PG8_WAIT_L(0); PG8_BAR; PG8_MMA(0, 0, At, B0); PG8_MMA(0, 1, At, B1); PG8_BAR; PG8_SCHED;
            PG8_LDA(At, 1, 1); PG8_STAGE(PG8_SB(1, 0), b3, voffB); PG8_STAGE(PG8_SB(1, 1), b3 + hstep, voffB); PG8_STAGE(PG8_SA(1, 0), a3, voffA);
            PG8_WAIT_V(8); PG8_WAIT_L(0); PG8_BAR; PG8_MMA(1, 0, At, B0); PG8_MMA(1, 1, At, B1); PG8_BAR; PG8_SCHED;
            } else {
            PG8_LDB(B0, 0, 0); PG8_SCHED; PG8_LDA(At, 0, 0); PG8_STAGE(PG8_SA(1, 1), a1 + hstep, voffA);
            PG8_WAIT_L(8); PG8_BAR; PG8_WAIT_L(0); PG8_MMA(0, 0, At, B0); PG8_BAR; PG8_SCHED;
            PG8_LDB(B1, 0, 1); PG8_STAGE(PG8_SB(0, 0), b2, voffB);
            PG8_BAR; PG8_WAIT_L(0); PG8_MMA(0, 1, At, B1); PG8_BAR;
            PG8_LDA(At, 0, 1); PG8_STAGE(PG8_SA(0, 0), a2, voffA);
            PG8_BAR; PG8_WAIT_L(0); PG8_MMA(1, 0, At, B0); PG8_BAR; PG8_SCHED;
            PG8_STAGE(PG8_SB(0, 1), b2 + hstep, voffB);
            PG8_WAIT_V(6); PG8_BAR; PG8_MMA(1, 1, At, B1); PG8_BAR;
            PG8_LDB(B0, 1, 0); PG8_SCHED; PG8_LDA(At, 1, 0); PG8_STAGE(PG8_SA(0, 1), a2 + hstep, voffA);
            PG8_WAIT_L(8); PG8_BAR; PG8_WAIT_L(0); PG8_MMA(0, 0, At, B0); PG8_BAR; PG8_SCHED;
            PG8_LDB(B1, 1, 1); PG8_STAGE(PG8_SB(1, 0), b3, voffB);
            PG8_BAR; PG8_WAIT_L(0); PG8_MMA(0, 1, At, B1); PG8_BAR;
            PG8_LDA(At, 1, 1); PG8_STAGE(PG8_SA(1, 0), a3, voffA);
            PG8_BAR; PG8_WAIT_L(0); PG8_MMA(1, 0, At, B0); PG8_BAR; PG8_SCHED;
            PG8_STAGE(PG8_SB(1, 1), b3 + hstep, voffB);
            PG8_WAIT_V(6); PG8_BAR; PG8_MMA(1, 1, At, B1); PG8_BAR;
            }
        }
        if constexpr (ALIGN_EPI) { if (wr == 0) PG8_BAR; }
        if constexpr (!Epi::AFTER_DRAIN) { E(acc, cur, wr, wc, fr, fq); S.done(cur); }
        if (!has_next) break;
#pragma unroll
        for (int a = 0; a < 2; ++a)
#pragma unroll
            for (int b = 0; b < 2; ++b)
#pragma unroll
                for (int m = 0; m < 4; ++m)
#pragma unroll
                    for (int n = 0; n < 2; ++n) acc[a][b][m][n] = (f32x4){0.f, 0.f, 0.f, 0.f};
        cur = nxt; cA = nA; cB = nB; ++ui;
        if constexpr (ALIGN_EPI) { if (wr == 1) PG8_BAR; }
    }
    PG8_WAIT_V(0);
    if constexpr (!ALIGN_EPI) { if (wr == 0) PG8_BAR; }
    PG8_BAR;
    if constexpr (Epi::AFTER_DRAIN) { E.fused(acc, cur, wr, wc, fr, fq, lds, wid, lane); S.done(cur); }
#undef PG8_SA
#undef PG8_SB
#undef PG8_STAGE
#undef PG8_LDA
#undef PG8_LDB
#undef PG8_MMA
#undef PG8_WAIT_V
#undef PG8_WAIT_L
#undef PG8_BAR
#undef PG8_SCHED
}
}
namespace att {
constexpr int D = 128, NW = 8, QBLK = 32, KVBLK = 64;
constexpr float SCALE = 0.088388347648318440f;
constexpr float THR = 8.f;
#ifndef ATT_SDEPTH
#define ATT_SDEPTH 2
#endif
#ifndef ATT_SDEPTH_FIX
#define ATT_SDEPTH_FIX 1
#endif
#ifndef ATT_FIXQLDS
#define ATT_FIXQLDS 0
#endif
#ifndef ATT_PVILP
#define ATT_PVILP 0
#endif
#ifndef ATT_PVPIPE
#define ATT_PVPIPE 0
#endif
#ifndef ATT_RING3
#define ATT_RING3 0
#endif
constexpr int SDEPTH = ATT_SDEPTH;
constexpr int LDQ = 1024, LDK = 128;
constexpr size_t SHM_V = KVBLK * D * 2, SHM_K = KVBLK * D * 2, SHM_ATTN = 2 * SHM_V + 2 * SHM_K + NW * 64 * 4;
#define KSWZ(row, colB) ((row) * 256 + ((colB) ^ (((row) & 7) << 4)))
#define SBAR() __builtin_amdgcn_sched_barrier(0)
__device__ __forceinline__ int crow(int r, int hi) { return (r & 3) + 8 * (r >> 2) + 4 * hi; }
template <bool MASK, bool FIX = false>
__device__ __forceinline__ void partialSM(f32x16& p0, f32x16& p1, float& m_reg, float& mn, float& alpha, int dm, int hi) {
  constexpr float C = SCALE * 1.4426950408889634f;
  if (MASK) {
#pragma unroll
    for (int r = 0; r < 16; ++r) { const int k0 = dm + crow(r, hi); if (k0 > 128 || k0 < -128) p0[r] = -1e30f; if (k0 + 32 > 128 || k0 + 32 < -128) p1[r] = -1e30f; }
  }
  if (FIX) {
    mn = m_reg; alpha = 1.f;
#pragma unroll
    for (int r = 0; r < 16; ++r) p0[r] = __builtin_amdgcn_exp2f(p0[r]);
    return;
  }
  {
  float pmax = p0[0];
#pragma unroll
  for (int r = 1; r < 16; ++r) pmax = fmaxf(pmax, p0[r]);
#pragma unroll
  for (int r = 0; r < 16; ++r) pmax = fmaxf(pmax, p1[r]);
  { auto rr = __builtin_amdgcn_permlane32_swap(__float_as_uint(pmax), __float_as_uint(pmax), false, false);
    pmax = fmaxf(__uint_as_float(rr[0]), __uint_as_float(rr[1])); }
  if (__builtin_expect(__all(pmax - m_reg <= THR / SCALE), 1)) { mn = m_reg; alpha = 1.f; }
  else { mn = fmaxf(m_reg, pmax); alpha = __builtin_amdgcn_exp2f((m_reg - mn) * C); m_reg = mn; }
  }
  float mnC = -mn * C;
#pragma unroll
  for (int r = 0; r < 16; ++r) p0[r] = fmaf(p0[r], C, mnC);
#pragma unroll
  for (int r = 0; r < 16; ++r) p1[r] = fmaf(p1[r], C, mnC);
#pragma unroll
  for (int r = 0; r < 16; ++r) p0[r] = __builtin_amdgcn_exp2f(p0[r]);
}
template <bool FIX = false>
__device__ __forceinline__ void finishSM(f32x16& p0, f32x16& p1, float alpha, float& l_reg, bf16x8& pa0, bf16x8& pa1, bf16x8& pa2, bf16x8& pa3) {
#pragma unroll
  for (int r = 0; r < 16; ++r) p1[r] = __builtin_amdgcn_exp2f(p1[r]);
  float ps = 0;
#pragma unroll
  for (int r = 0; r < 16; ++r) ps += p0[r];
#pragma unroll
  for (int r = 0; r < 16; ++r) ps += p1[r];
  if (FIX) {
    l_reg += ps;
#define PK8(P, BASE, OUT) do { u32x4 w = {cvt_pk_bf16(P[BASE + 0], P[BASE + 1]), cvt_pk_bf16(P[BASE + 2], P[BASE + 3]), cvt_pk_bf16(P[BASE + 4], P[BASE + 5]), cvt_pk_bf16(P[BASE + 6], P[BASE + 7])}; OUT = *reinterpret_cast<bf16x8*>(&w); } while (0)
    PK8(p0, 0, pa0); PK8(p0, 8, pa1); PK8(p1, 0, pa2); PK8(p1, 8, pa3);
#undef PK8
    return;
  }
  { auto rr = __builtin_amdgcn_permlane32_swap(__float_as_uint(ps), __float_as_uint(ps), false, false);
    ps = __uint_as_float(rr[0]) + __uint_as_float(rr[1]); }
  l_reg = l_reg * alpha + ps;
#define PK4(P, BASE, OUT) do { unsigned a0 = cvt_pk_bf16(P[BASE + 0], P[BASE + 1]), a1 = cvt_pk_bf16(P[BASE + 2], P[BASE + 3]);   \
    unsigned b0 = cvt_pk_bf16(P[BASE + 4], P[BASE + 5]), b1 = cvt_pk_bf16(P[BASE + 6], P[BASE + 7]);                              \
    auto r0 = __builtin_amdgcn_permlane32_swap(a0, b0, false, false); auto r1 = __builtin_amdgcn_permlane32_swap(a1, b1, false, false); \
    u32x4 w = {r0[0], r1[0], r0[1], r1[1]}; OUT = *reinterpret_cast<bf16x8*>(&w); } while (0)
  PK4(p0, 0, pa0); PK4(p0, 8, pa1); PK4(p1, 0, pa2); PK4(p1, 8, pa3);
#undef PK4
}
template <bool QLDS, bool FIX = false>
__device__ __forceinline__ void qkt(f32x16& p0, f32x16& p1, const bf16_t* Ks, const bf16x8* qr, unsigned qaddr, int r32, int hi, const f32x16& negm) {
  if (FIX) { p0 = negm; p1 = negm; } else { p0 = f32x16{}; p1 = f32x16{}; }
  if (QLDS) asm volatile("" : "+v"(qaddr));
  const LAS bf16x8* ql = (const LAS bf16x8*)(uintptr_t)qaddr;
#pragma unroll
  for (int d0 = 0; d0 < 8; ++d0) { int cb = (d0 * 16 + hi * 8) * 2; const bf16x8 qf = QLDS ? ql[d0 * 64] : qr[d0];
    bf16x8 b0 = *reinterpret_cast<const bf16x8*>((const char*)Ks + KSWZ(r32, cb));
    bf16x8 b1 = *reinterpret_cast<const bf16x8*>((const char*)Ks + KSWZ(32 + r32, cb));
    p0 = __builtin_amdgcn_mfma_f32_32x32x16_bf16(b0, qf, p0, 0, 0, 0);
    p1 = __builtin_amdgcn_mfma_f32_32x32x16_bf16(b1, qf, p1, 0, 0, 0); }
}
__device__ __forceinline__ int v_st(int k, int c) { const int kk = (k & ~0xC) | ((k & 4) << 1) | ((k & 8) >> 1); return ((kk >> 3) * 4 + (c >> 5)) * 512 + ((kk & 7) * 32 + (c & 31)) * 2; }
__device__ __forceinline__ int v_rd_base(int lane) { return ((lane & 3) << 3) | (((lane >> 2) & 3) << 6) | (((lane >> 4) & 1) << 5) | (((lane >> 5) & 1) << 8); }
constexpr int v_rd_off(int d0, int ks, int half) { return d0 * 512 + ks * 4096 + half * 2048; }
template <int OFF> __device__ __forceinline__ s16x4 tr_read(int vb) {
  s16x4 r; asm volatile("ds_read_b64_tr_b16 %0, %1 offset:%2" : "=&v"(r) : "v"(vb), "i"(OFF) : "memory"); return r;
}
#define PKLH(L, H) (bf16x8){L[0], L[1], L[2], L[3], H[0], H[1], H[2], H[3]}
template <int D0> __device__ __forceinline__ void pv_one(f32x16& od, int vb, bf16x8 pa0, bf16x8 pa1, bf16x8 pa2, bf16x8 pa3) {
  const s16x4 l0 = tr_read<v_rd_off(D0, 0, 0)>(vb), h0 = tr_read<v_rd_off(D0, 0, 1)>(vb), l1 = tr_read<v_rd_off(D0, 1, 0)>(vb), h1 = tr_read<v_rd_off(D0, 1, 1)>(vb);
  const s16x4 l2 = tr_read<v_rd_off(D0, 2, 0)>(vb), h2 = tr_read<v_rd_off(D0, 2, 1)>(vb), l3 = tr_read<v_rd_off(D0, 3, 0)>(vb), h3 = tr_read<v_rd_off(D0, 3, 1)>(vb);
  asm volatile("s_waitcnt lgkmcnt(0)" ::: "memory"); SBAR();
  od = __builtin_amdgcn_mfma_f32_32x32x16_bf16(pa0, PKLH(l0, h0), od, 0, 0, 0);
  od = __builtin_amdgcn_mfma_f32_32x32x16_bf16(pa1, PKLH(l1, h1), od, 0, 0, 0);
  od = __builtin_amdgcn_mfma_f32_32x32x16_bf16(pa2, PKLH(l2, h2), od, 0, 0, 0);
  od = __builtin_amdgcn_mfma_f32_32x32x16_bf16(pa3, PKLH(l3, h3), od, 0, 0, 0);
}
#define PV_RD(D0, L0, H0, L1, H1, L2, H2, L3, H3) do { L0 = tr_read<v_rd_off(D0, 0, 0)>(vb); H0 = tr_read<v_rd_off(D0, 0, 1)>(vb); L1 = tr_read<v_rd_off(D0, 1, 0)>(vb); H1 = tr_read<v_rd_off(D0, 1, 1)>(vb); \
    L2 = tr_read<v_rd_off(D0, 2, 0)>(vb); H2 = tr_read<v_rd_off(D0, 2, 1)>(vb); L3 = tr_read<v_rd_off(D0, 3, 0)>(vb); H3 = tr_read<v_rd_off(D0, 3, 1)>(vb); } while (0)
#define PV_MM(OD, L0, H0, L1, H1, L2, H2, L3, H3) do { OD = __builtin_amdgcn_mfma_f32_32x32x16_bf16(pa0, PKLH(L0, H0), OD, 0, 0, 0); OD = __builtin_amdgcn_mfma_f32_32x32x16_bf16(pa1, PKLH(L1, H1), OD, 0, 0, 0); \
    OD = __builtin_amdgcn_mfma_f32_32x32x16_bf16(pa2, PKLH(L2, H2), OD, 0, 0, 0); OD = __builtin_amdgcn_mfma_f32_32x32x16_bf16(pa3, PKLH(L3, H3), OD, 0, 0, 0); } while (0)
template <bool ILP = false>
__device__ __forceinline__ void pv_d0(f32x16* o, int vb, bf16x8 pa0, bf16x8 pa1, bf16x8 pa2, bf16x8 pa3) {
#if ATT_PVPIPE
  s16x4 al0, ah0, al1, ah1, al2, ah2, al3, ah3, bl0, bh0, bl1, bh1, bl2, bh2, bl3, bh3;
  PV_RD(0, al0, ah0, al1, ah1, al2, ah2, al3, ah3); PV_RD(1, bl0, bh0, bl1, bh1, bl2, bh2, bl3, bh3);
  asm volatile("s_waitcnt lgkmcnt(8)" ::: "memory"); SBAR(); PV_MM(o[0], al0, ah0, al1, ah1, al2, ah2, al3, ah3); SBAR();
  PV_RD(2, al0, ah0, al1, ah1, al2, ah2, al3, ah3);
  asm volatile("s_waitcnt lgkmcnt(8)" ::: "memory"); SBAR(); PV_MM(o[1], bl0, bh0, bl1, bh1, bl2, bh2, bl3, bh3); SBAR();
  PV_RD(3, bl0, bh0, bl1, bh1, bl2, bh2, bl3, bh3);
  asm volatile("s_waitcnt lgkmcnt(8)" ::: "memory"); SBAR(); PV_MM(o[2], al0, ah0, al1, ah1, al2, ah2, al3, ah3); SBAR();
  asm volatile("s_waitcnt lgkmcnt(0)" ::: "memory"); SBAR(); PV_MM(o[3], bl0, bh0, bl1, bh1, bl2, bh2, bl3, bh3);
#elif ATT_PVILP
  if constexpr (ILP)
  { s16x4 al0, ah0, al1, ah1, al2, ah2, al3, ah3, bl0, bh0, bl1, bh1, bl2, bh2, bl3, bh3;
#define PV_ILP(DA, DB) do { PV_RD(DA, al0, ah0, al1, ah1, al2, ah2, al3, ah3); PV_RD(DB, bl0, bh0, bl1, bh1, bl2, bh2, bl3, bh3); \
    asm volatile("s_waitcnt lgkmcnt(0)" ::: "memory"); SBAR(); \
    o[DA] = __builtin_amdgcn_mfma_f32_32x32x16_bf16(pa0, PKLH(al0, ah0), o[DA], 0, 0, 0); o[DB] = __builtin_amdgcn_mfma_f32_32x32x16_bf16(pa0, PKLH(bl0, bh0), o[DB], 0, 0, 0); \
    o[DA] = __builtin_amdgcn_mfma_f32_32x32x16_bf16(pa1, PKLH(al1, ah1), o[DA], 0, 0, 0); o[DB] = __builtin_amdgcn_mfma_f32_32x32x16_bf16(pa1, PKLH(bl1, bh1), o[DB], 0, 0, 0); \
    o[DA] = __builtin_amdgcn_mfma_f32_32x32x16_bf16(pa2, PKLH(al2, ah2), o[DA], 0, 0, 0); o[DB] = __builtin_amdgcn_mfma_f32_32x32x16_bf16(pa2, PKLH(bl2, bh2), o[DB], 0, 0, 0); \
    o[DA] = __builtin_amdgcn_mfma_f32_32x32x16_bf16(pa3, PKLH(al3, ah3), o[DA], 0, 0, 0); o[DB] = __builtin_amdgcn_mfma_f32_32x32x16_bf16(pa3, PKLH(bl3, bh3), o[DB], 0, 0, 0); SBAR(); } while (0)
    PV_ILP(0, 1); PV_ILP(2, 3);
#undef PV_ILP
  } else {
  pv_one<0>(o[0], vb, pa0, pa1, pa2, pa3); pv_one<1>(o[1], vb, pa0, pa1, pa2, pa3); pv_one<2>(o[2], vb, pa0, pa1, pa2, pa3); pv_one<3>(o[3], vb, pa0, pa1, pa2, pa3); }
#else
  pv_one<0>(o[0], vb, pa0, pa1, pa2, pa3); pv_one<1>(o[1], vb, pa0, pa1, pa2, pa3); pv_one<2>(o[2], vb, pa0, pa1, pa2, pa3); pv_one<3>(o[3], vb, pa0, pa1, pa2, pa3);
#endif
}

template <bool WIN, bool FIX = false>
__device__ __forceinline__ void attn_unit(const bf16_t* Qb, const bf16_t* __restrict__ Kh, const bf16_t* __restrict__ Vh, bf16_t* Ob, int NT, int lo_key, int dbase, float m_init, float l_init, char* lds, int tid_in) {
  int tid_o = tid_in; asm volatile("" : "+v"(tid_o));
  const int tid = tid_o, wid = tid >> 6, lane = tid & 63, r32 = lane & 31, hi = lane >> 5;
  constexpr int SD = FIX ? ATT_SDEPTH_FIX : att::SDEPTH;
  constexpr bool RING = (!WIN) && (ATT_RING3 != 0); constexpr int NBUF = RING ? 3 : 2;
  bf16_t* V_lds = (bf16_t*)lds; bf16_t* K_lds = (bf16_t*)(lds + NBUF * SHM_V);
  float* ws = (float*)(lds + NBUF * SHM_V + NBUF * SHM_K) + wid * 64; float* li_l = ws; float* al_l = ws + 32;
  float m_reg = m_init, l_reg = l_init; f32x16 o[4] = {}; bf16x8 qr[8];
  const unsigned qaddr = (unsigned)(uintptr_t)lds + 69632u + (unsigned)wid * 8192u + (unsigned)lane * 16u;
  const bf16_t* Qw = Qb + (long)(wid * QBLK + r32) * LDQ + hi * 8;
#pragma unroll
  for (int d0 = 0; d0 < 8; ++d0) qr[d0] = *reinterpret_cast<const bf16x8*>(Qw + d0 * 16);
  f32x16 negm = {};
  if constexpr (FIX) {
    constexpr float CQ = SCALE * 1.4426950408889634f;
#pragma unroll
    for (int d0 = 0; d0 < 8; ++d0) { u32x4 w = *reinterpret_cast<u32x4*>(&qr[d0]);
      w.x = cvt_pk_bf16(bf_lo(w.x) * CQ, bf_hi(w.x) * CQ); w.y = cvt_pk_bf16(bf_lo(w.y) * CQ, bf_hi(w.y) * CQ); w.z = cvt_pk_bf16(bf_lo(w.z) * CQ, bf_hi(w.z) * CQ); w.w = cvt_pk_bf16(bf_lo(w.w) * CQ, bf_hi(w.w) * CQ);
      qr[d0] = *reinterpret_cast<bf16x8*>(&w); }
    float nb = -m_init * 1.4426950408889634f; asm volatile("" : "+v"(nb));
#pragma unroll
    for (int r = 0; r < 16; ++r) negm[r] = nb;
    asm volatile("" : "+v"(negm));
  }
  constexpr bool QL = WIN || (FIX && ATT_FIXQLDS);
  if constexpr (QL) {
#pragma unroll
    for (int d0 = 0; d0 < 8; ++d0) ((LAS bf16x8*)(uintptr_t)qaddr)[d0 * 64] = qr[d0];
  }
  const int sr = tid >> 4, sc = (tid & 15) * 8, vst0 = v_st(sr, sc), vst1 = v_st(32 + sr, sc);
  const int vb0 = (int)(uintptr_t)V_lds + v_rd_base(lane);
  const int srk = FIX ? ((sr & ~0xC) | ((sr & 4) << 1) | ((sr & 8) >> 1)) : sr;
  struct { bf16x8 vs0, vs1, ks0, ks1; } sr_[SD];
  const int dmw = dbase - wid * QBLK - r32;
#define KROW(j) (WIN ? ((j) < 4 ? (j) * KVBLK : lo_key + ((j) - 4) * KVBLK) : (j) * KVBLK)
#define DMJ(j) (dmw + ((j) - 4) * KVBLK)
#define SLOAD(i, k0) do { sr_[i].vs0 = *reinterpret_cast<const bf16x8*>(&Vh[(long)((k0) + sr) * LDK + sc]); sr_[i].vs1 = *reinterpret_cast<const bf16x8*>(&Vh[(long)((k0) + 32 + sr) * LDK + sc]); \
    sr_[i].ks0 = *reinterpret_cast<const bf16x8*>(&Kh[(long)((k0) + sr) * LDK + sc]); sr_[i].ks1 = *reinterpret_cast<const bf16x8*>(&Kh[(long)((k0) + 32 + sr) * LDK + sc]); } while (0)
#define SWRITE(b, i) do { *(bf16x8*)((char*)V_lds + (b) * SHM_V + vst0) = sr_[i].vs0;          \
    *(bf16x8*)((char*)V_lds + (b) * SHM_V + vst1) = sr_[i].vs1; int kc = sc * 2;               \
    *(bf16x8*)((char*)K_lds + (b) * SHM_K + KSWZ(srk, kc)) = sr_[i].ks0;                       \
    *(bf16x8*)((char*)K_lds + (b) * SHM_K + KSWZ(32 + srk, kc)) = sr_[i].ks1; } while (0)
#define SWAIT() do { if (SD == 2) asm volatile("s_waitcnt vmcnt(4)" ::: "memory"); else asm volatile("s_waitcnt vmcnt(0)" ::: "memory"); } while (0)
#define RESC(a) do { if (!FIX && __any((a) < 1.f)) { if (hi == 0) al_l[r32] = (a); asm volatile("s_waitcnt lgkmcnt(0)" ::: "memory"); \
    _Pragma("unroll") for (int d = 0; d < 4; ++d) _Pragma("unroll") for (int r = 0; r < 16; ++r) o[d][r] *= al_l[crow(r, hi)]; } } while (0)
  f32x16 pA0, pA1, pB0, pB1; float mnA, mnB, alA, alB; bf16x8 pa0, pa1, pa2, pa3;
  constexpr int SE = 0, SO = SD - 1;
  if constexpr (RING) {
#define RWRITE(off) do { *(bf16x8*)((char*)V_lds + (off) + vst0) = sr_[0].vs0; *(bf16x8*)((char*)V_lds + (off) + vst1) = sr_[0].vs1; const int kc_ = sc * 2; \
    *(bf16x8*)((char*)K_lds + (off) + KSWZ(srk, kc_)) = sr_[0].ks0; *(bf16x8*)((char*)K_lds + (off) + KSWZ(32 + srk, kc_)) = sr_[0].ks1; } while (0)
#define ROT3() do { const int t_ = o_prev; o_prev = o_cur; o_cur = o_next; o_next = t_; } while (0)
    int o_prev = 0, o_cur = (int)SHM_V, o_next = 2 * (int)SHM_V;
    SLOAD(0, KROW(0)); asm volatile("s_waitcnt vmcnt(0)" ::: "memory"); RWRITE(0); __syncthreads();
    qkt<QL, FIX>(pA0, pA1, K_lds, qr, qaddr, r32, hi, negm); partialSM<false, FIX>(pA0, pA1, m_reg, mnA, alA, 0, hi);
    SLOAD(0, KROW(1)); asm volatile("s_waitcnt vmcnt(0)" ::: "memory"); RWRITE(o_cur);
    if (2 < NT) SLOAD(0, KROW(2));
    __syncthreads();
    for (int j = 1; j + 1 < NT; j += 2) {
      asm volatile("s_waitcnt vmcnt(0)" ::: "memory"); RWRITE(o_next);
      SBAR(); qkt<QL, FIX>(pB0, pB1, (bf16_t*)((char*)K_lds + o_cur), qr, qaddr, r32, hi, negm);
      finishSM<FIX>(pA0, pA1, alA, l_reg, pa0, pa1, pa2, pa3); SBAR();
      if (j + 2 < NT) SLOAD(0, KROW(j + 2)); SBAR();
      pv_d0<FIX>(o, vb0 + o_prev, pa0, pa1, pa2, pa3);
      partialSM<false, FIX>(pB0, pB1, m_reg, mnB, alB, 0, hi);
      RESC(alB); __syncthreads(); ROT3();
      if (j + 2 < NT) { asm volatile("s_waitcnt vmcnt(0)" ::: "memory"); RWRITE(o_next); }
      SBAR(); qkt<QL, FIX>(pA0, pA1, (bf16_t*)((char*)K_lds + o_cur), qr, qaddr, r32, hi, negm);
      finishSM<FIX>(pB0, pB1, alB, l_reg, pa0, pa1, pa2, pa3); SBAR();
      if (j + 3 < NT) SLOAD(0, KROW(j + 3)); SBAR();
      pv_d0<FIX>(o, vb0 + o_prev, pa0, pa1, pa2, pa3);
      partialSM<false, FIX>(pA0, pA1, m_reg, mnA, alA, 0, hi);
      RESC(alA); __syncthreads(); ROT3();
    }
    SBAR(); qkt<QL, FIX>(pB0, pB1, (bf16_t*)((char*)K_lds + o_cur), qr, qaddr, r32, hi, negm);
    finishSM<FIX>(pA0, pA1, alA, l_reg, pa0, pa1, pa2, pa3); SBAR();
    pv_d0<FIX>(o, vb0 + o_prev, pa0, pa1, pa2, pa3);
    partialSM<false, FIX>(pB0, pB1, m_reg, mnB, alB, 0, hi);
    RESC(alB);
    finishSM<FIX>(pB0, pB1, alB, l_reg, pa0, pa1, pa2, pa3); SBAR();
    pv_d0<FIX>(o, vb0 + o_cur, pa0, pa1, pa2, pa3);
#undef RWRITE
#undef ROT3
  } else {
  SLOAD(SE, KROW(0)); asm volatile("s_waitcnt vmcnt(0)" ::: "memory"); SWRITE(0, SE); __syncthreads();
  qkt<QL, FIX>(pA0, pA1, K_lds, qr, qaddr, r32, hi, negm); partialSM<false, FIX>(pA0, pA1, m_reg, mnA, alA, 0, hi);
  SLOAD(SO, KROW(1)); if (SD == 2) { if (2 < NT) SLOAD(SE, KROW(2)); }
  SWAIT(); SWRITE(1, SO); __syncthreads();
  for (int j = 1; j + 1 < NT; j += 2) {
    SBAR(); qkt<QL, FIX>(pB0, pB1, (bf16_t*)((char*)K_lds + SHM_K), qr, qaddr, r32, hi, negm);
    finishSM<FIX>(pA0, pA1, alA, l_reg, pa0, pa1, pa2, pa3); SBAR();
    SLOAD(SO, KROW(j + SD)); SBAR();
    pv_d0<FIX>(o, vb0, pa0, pa1, pa2, pa3);
    if (WIN && j >= 4) partialSM<true>(pB0, pB1, m_reg, mnB, alB, DMJ(j), hi); else partialSM<false, FIX>(pB0, pB1, m_reg, mnB, alB, 0, hi);
    __syncthreads(); SWAIT(); SWRITE(0, SE);
    RESC(alB); __syncthreads();
    SBAR(); qkt<QL, FIX>(pA0, pA1, K_lds, qr, qaddr, r32, hi, negm);
    finishSM<FIX>(pB0, pB1, alB, l_reg, pa0, pa1, pa2, pa3); SBAR();
    if (SD == 1 || j + 3 < NT) SLOAD(SE, KROW(j + 1 + SD)); SBAR();
    pv_d0<FIX>(o, vb0 + (int)SHM_V, pa0, pa1, pa2, pa3);
    if (WIN && j + 1 >= 4) partialSM<true>(pA0, pA1, m_reg, mnA, alA, DMJ(j + 1), hi); else partialSM<false, FIX>(pA0, pA1, m_reg, mnA, alA, 0, hi);
    __syncthreads(); SWAIT(); SWRITE(1, SO);
    RESC(alA); __syncthreads();
  }
  SBAR(); qkt<QL, FIX>(pB0, pB1, (bf16_t*)((char*)K_lds + SHM_K), qr, qaddr, r32, hi, negm);
  finishSM<FIX>(pA0, pA1, alA, l_reg, pa0, pa1, pa2, pa3); SBAR();
  pv_d0<FIX>(o, vb0, pa0, pa1, pa2, pa3);
  if (WIN) partialSM<true>(pB0, pB1, m_reg, mnB, alB, DMJ(NT - 1), hi); else partialSM<false, FIX>(pB0, pB1, m_reg, mnB, alB, 0, hi);
  __syncthreads(); RESC(alB);
  finishSM<FIX>(pB0, pB1, alB, l_reg, pa0, pa1, pa2, pa3); SBAR();
  pv_d0<FIX>(o, vb0 + (int)SHM_V, pa0, pa1, pa2, pa3);
  }
  if (FIX) { auto rr = __builtin_amdgcn_permlane32_swap(__float_as_uint(l_reg), __float_as_uint(l_reg), false, false); l_reg = __uint_as_float(rr[0]) + __uint_as_float(rr[1]); }
  if (hi == 0) li_l[r32] = l_reg; asm volatile("s_waitcnt lgkmcnt(0)" ::: "memory");
  float rli[16];
#pragma unroll
  for (int r = 0; r < 16; ++r) rli[r] = __builtin_amdgcn_rcpf(li_l[crow(r, hi)]);
  bf16_t* Ow = Ob + (long)(wid * QBLK) * LDQ;
#pragma unroll
  for (int r = 0; r < 16; ++r) { int orow = crow(r, hi);
#pragma unroll
    for (int d0 = 0; d0 < 4; ++d0) Ow[(long)orow * LDQ + d0 * 32 + r32] = f2bf(o[d0][r] * rli[r]); }
  __syncthreads();
#undef KROW
#undef DMJ
#undef SLOAD
#undef SWRITE
#undef SWAIT
#undef RESC
}

template <int OFF> __device__ __forceinline__ void dft_blk2(f32x16& a0, f32x16& a1, int vb, bf16x8 u0, bf16x8 u1, bf16x8 u2, bf16x8 u3, bf16x8 w0, bf16x8 w1, bf16x8 w2, bf16x8 w3) {
  const s16x4 l0 = tr_read<OFF + v_rd_off(0, 0, 0)>(vb), h0 = tr_read<OFF + v_rd_off(0, 0, 1)>(vb), l1 = tr_read<OFF + v_rd_off(0, 1, 0)>(vb), h1 = tr_read<OFF + v_rd_off(0, 1, 1)>(vb);
  const s16x4 l2 = tr_read<OFF + v_rd_off(0, 2, 0)>(vb), h2 = tr_read<OFF + v_rd_off(0, 2, 1)>(vb), l3 = tr_read<OFF + v_rd_off(0, 3, 0)>(vb), h3 = tr_read<OFF + v_rd_off(0, 3, 1)>(vb);
  asm volatile("s_waitcnt lgkmcnt(0)" ::: "memory"); SBAR();
  a0 = __builtin_amdgcn_mfma_f32_32x32x16_bf16(u0, PKLH(l0, h0), a0, 0, 0, 0); a1 = __builtin_amdgcn_mfma_f32_32x32x16_bf16(w0, PKLH(l0, h0), a1, 0, 0, 0);
  a0 = __builtin_amdgcn_mfma_f32_32x32x16_bf16(u1, PKLH(l1, h1), a0, 0, 0, 0); a1 = __builtin_amdgcn_mfma_f32_32x32x16_bf16(w1, PKLH(l1, h1), a1, 0, 0, 0);
  a0 = __builtin_amdgcn_mfma_f32_32x32x16_bf16(u2, PKLH(l2, h2), a0, 0, 0, 0); a1 = __builtin_amdgcn_mfma_f32_32x32x16_bf16(w2, PKLH(l2, h2), a1, 0, 0, 0);
  a0 = __builtin_amdgcn_mfma_f32_32x32x16_bf16(u3, PKLH(l3, h3), a0, 0, 0, 0); a1 = __builtin_amdgcn_mfma_f32_32x32x16_bf16(w3, PKLH(l3, h3), a1, 0, 0, 0);
}
template <int STAGE>
__device__ __forceinline__ void dft_phase(const bf16_t* __restrict__ inR, const bf16_t* __restrict__ inI, bf16_t* outR, bf16_t* outI, const f32x2* __restrict__ TW, const bf16x8* __restrict__ WT, int vcu, int G, char* lds, int tid_in) {
  int tid_o = tid_in; asm volatile("" : "+v"(tid_o));
  const int tid = tid_o, wid = tid >> 6, lane = tid & 63, r32 = lane & 31, hi = lane >> 5, kr = wid & 3, dh = wid >> 2;
  bf16x8 Wc[8], Ws[8];
#pragma unroll
  for (int ks = 0; ks < 8; ++ks) { Wc[ks] = WT[((kr * 8 + ks) * 64 + lane) * 2]; Ws[ks] = WT[((kr * 8 + ks) * 64 + lane) * 2 + 1]; }
  const int sr = tid >> 4, sc = (tid & 15) * 8;
  int vst[4];
#pragma unroll
  for (int i = 0; i < 4; ++i) vst[i] = (i >> 1) * 16384 + v_st((i & 1) * 32 + sr, sc);
  const int vb = (int)(uintptr_t)lds + v_rd_base(lane) + dh * 1024;
  bf16x8 stR[4], stI[4];
  constexpr int NTILES = NB * 128 * 8;
#define DLOAD(it_) do { const int b_ = (it_) >> 10, s_ = ((it_) >> 3) & 127, c0_ = ((it_) & 7) * 128; \
    _Pragma("unroll") for (int i = 0; i < 4; ++i) { const int j_ = i * 32 + sr; const long row_ = (STAGE == 1) ? ((long)b_ * SEQ + 128 * j_ + s_) : ((long)b_ * SEQ + 128 * s_ + j_); \
      stR[i] = *reinterpret_cast<const bf16x8*>(inR + row_ * DM + c0_ + sc); if (STAGE == 2) stI[i] = *reinterpret_cast<const bf16x8*>(inI + row_ * DM + c0_ + sc); } } while (0)
  int it = vcu;
  if (it < NTILES) DLOAD(it);
  for (; it < NTILES; it += G) {
    const int b = it >> 10, s = (it >> 3) & 127, c0 = (it & 7) * 128;
#pragma unroll
    for (int i = 0; i < 4; ++i) { *(bf16x8*)(lds + vst[i]) = stR[i]; if (STAGE == 2) *(bf16x8*)(lds + 32768 + vst[i]) = stI[i]; }
    __syncthreads();
    if (it + G < NTILES) DLOAD(it + G);
    bf16_t* stg = (bf16_t*)(lds + 65536 + wid * 8192);
    const bool active = !(STAGE == 2 && HERM && kr >= 2);
#define DFT_DD(DDOFF, DD) do { if (active) { f32x16 aR = {}, aI = {}; \
    dft_blk2<DDOFF>(aR, aI, vb, Wc[0], Wc[1], Wc[2], Wc[3], Ws[0], Ws[1], Ws[2], Ws[3]); \
    dft_blk2<16384 + DDOFF>(aR, aI, vb, Wc[4], Wc[5], Wc[6], Wc[7], Ws[4], Ws[5], Ws[6], Ws[7]); \
    if (STAGE == 2) { aI = -aI; \
      dft_blk2<32768 + DDOFF>(aI, aR, vb, Wc[0], Wc[1], Wc[2], Wc[3], Ws[0], Ws[1], Ws[2], Ws[3]); \
      dft_blk2<32768 + 16384 + DDOFF>(aI, aR, vb, Wc[4], Wc[5], Wc[6], Wc[7], Ws[4], Ws[5], Ws[6], Ws[7]); } \
    _Pragma("unroll") for (int r = 0; r < 16; ++r) { const int rw = crow(r, hi); float tc = 1.f, ts = 0.f; \
      if (STAGE == 1) { const f32x2 tw = TW[s * 128 + 32 * kr + rw]; tc = tw.x; ts = tw.y; } \
      const float oc = aR[r], os = aI[r]; \
      const float vr = (STAGE == 1) ? (oc * tc - os * ts) : oc, vi = (STAGE == 1) ? -(oc * ts + os * tc) : os; \
      stg[rw * 64 + DD * 32 + r32] = f2bf(vr); stg[2048 + rw * 64 + DD * 32 + r32] = f2bf(vi); } } } while (0)
    DFT_DD(0, 0); DFT_DD(512, 1);
#undef DFT_DD
    asm volatile("s_waitcnt lgkmcnt(0)" ::: "memory");
    if (active) { const int ch = lane & 7, colb = c0 + 64 * dh + ch * 8;
#pragma unroll
      for (int i = 0; i < 4; ++i) { const int row = i * 8 + (lane >> 3), ro = 32 * kr + row;
        const u32x4 vr = *(const u32x4*)(stg + row * 64 + ch * 8), vi = *(const u32x4*)(stg + 2048 + row * 64 + ch * 8);
        if (STAGE == 1) { const long orow = (long)b * SEQ + ro * 128 + s; *(u32x4*)(outR + orow * DM + colb) = vr; *(u32x4*)(outI + orow * DM + colb) = vi; }
        else if (HERM) { const long orow = (long)b * (SEQ / 2) + s + 128 * ro; *(u32x4*)(outR + orow * DM + colb) = vr; *(u32x4*)(outI + orow * DM + colb) = vi; }
        else { const long orow = (long)b * SEQ + s + 128 * ro; const int g = colb >> 8, cl = colb & 255; *(u32x4*)(outR + orow * 2048 + 512 * g + cl) = vr; *(u32x4*)(outR + orow * 2048 + 512 * g + 256 + cl) = vi; } } }
    asm volatile("s_waitcnt lgkmcnt(0)" ::: "memory");
    __syncthreads();
  }
#undef DLOAD
}
#undef SBAR
#undef KSWZ
}

struct Args {
    const float *x, *c, *ctx, *c_ctx, *mod_w, *mod_b, *norm_g, *w_in, *w_out, *q_g, *k_g, *sink, *w_f, *w_up, *conv_w, *conv_b, *w_down;
    float* out; unsigned char* ws;
};

template <bool HPERM = false>
__device__ __forceinline__ void transpose_item(const float* W, int K, int N, bf16_t* WT, int k0, int n0, int drow0, LAS float* scr, int lane) {
#pragma unroll 8
    for (int i = 0; i < 32; ++i) { const int kk = 2 * i + (lane >> 5); scr[kk * 33 + (lane & 31)] = W[(size_t)(k0 + kk) * N + n0 + (lane & 31)]; }
    asm volatile("s_waitcnt lgkmcnt(0)" ::: "memory");
    const int c = lane & 7;
#pragma unroll
    for (int j = 0; j < 4; ++j) { const int n = (lane >> 3) + 8 * j; const LAS float* s = scr + (8 * c) * 33 + n;
        int drow = drow0 + n;
        if (HPERM) { const int L = drow0 + n, d = L & 127; drow = (L & ~127) | (d & 0x40) | ((d & 0x10) << 1) | ((d & 0x0C) << 1) | ((d & 0x20) >> 3) | (d & 3); }
        u32x4 o; o.x = cvt_pk_bf16(s[0 * 33], s[1 * 33]); o.y = cvt_pk_bf16(s[2 * 33], s[3 * 33]); o.z = cvt_pk_bf16(s[4 * 33], s[5 * 33]); o.w = cvt_pk_bf16(s[6 * 33], s[7 * 33]);
        *(u32x4*)(WT + (size_t)drow * K + k0 + 8 * c) = o; }
    asm volatile("s_waitcnt lgkmcnt(0)" ::: "memory");
}
__device__ __forceinline__ int up_row(int n) { const int half = n >= DFF ? 1 : 0, j = n - half * DFF; return 256 * (j >> 7) + 128 * half + (j & 127); }

__device__ __forceinline__ void prologue(const Args& a, int vcu, int G, unsigned char* ldsg, LAS unsigned char* lds, int tid_in) {
    int tid_o = tid_in; asm volatile("" : "+v"(tid_o));
    const int tid = tid_o, lane = tid & 63, wave = tid >> 6;
    unsigned char* ws = a.ws;
    {
        LAS float* sv = (LAS float*)lds;
        LAS float* red = (LAS float*)(lds + 16384);
        for (int i = tid; i < 3 * 1024; i += 512) { const int v = i >> 10, k = i & 1023; const float cv = (v < 2) ? a.c[v * 1024 + k] : a.c_ctx[k]; sv[i] = cv / (1.0f + __expf(-cv)); }
        __syncthreads();
        for (int job = vcu; job < 2 * 96; job += G) {
            const int l = job / 96, j0 = (job % 96) * 64;
            const float* W = a.mod_w + (size_t)l * 1024 * 6144 + j0 + lane;
            float a0 = 0.f, a1 = 0.f, a2 = 0.f;
#pragma unroll 16
            for (int i = 0; i < 128; ++i) { const int k = wave + 8 * i; const float w = W[(size_t)k * 6144]; a0 += sv[k] * w; a1 += sv[1024 + k] * w; a2 += sv[2048 + k] * w; }
            red[(wave * 3 + 0) * 64 + lane] = a0; red[(wave * 3 + 1) * 64 + lane] = a1; red[(wave * 3 + 2) * 64 + lane] = a2;
            __syncthreads();
            if (tid < 192) { const int v = tid >> 6, cc = tid & 63; float s = a.mod_b[l * 6144 + j0 + cc];
#pragma unroll
                for (int w = 0; w < 8; ++w) s += red[(w * 3 + v) * 64 + cc];
                ((float*)(ws + WS_MOD))[(l * 3 + v) * 6144 + j0 + cc] = s; }
            __syncthreads();
        }
        __syncthreads();
    }
    {
        const int gt = vcu * 512 + tid, NT_ = G * 512;
        f32x2* rope = (f32x2*)(ws + WS_ROPE); f32x2* tw = (f32x2*)(ws + WS_TW);
        for (int i = gt; i < 256 * 32; i += NT_) { const int pos = i >> 5, f = i & 31; const float inv = powf(10000.0f, -(float)f / 32.0f); const float ang = (float)pos * inv; rope[i] = (f32x2){cosf(ang), sinf(ang)}; }
        u32x4* wt = (u32x4*)(ws + WS_DFTW);
        for (int i = gt; i < 4 * 8 * 64; i += NT_) { const int ln = i & 63, ks = (i >> 6) & 7, kr_ = i >> 9; const int row = 32 * kr_ + (ln & 31); float c[8], sn[8];
#pragma unroll
            for (int e = 0; e < 8; ++e) { const int k = 16 * ks + 8 * (ln >> 5) + e; sincospif((float)((row * k) & 127) * (1.0f / 64.0f), &sn[e], &c[e]); }
            wt[2 * i] = (u32x4){cvt_pk_bf16(c[0], c[1]), cvt_pk_bf16(c[2], c[3]), cvt_pk_bf16(c[4], c[5]), cvt_pk_bf16(c[6], c[7])};
            wt[2 * i + 1] = (u32x4){cvt_pk_bf16(sn[0], sn[1]), cvt_pk_bf16(sn[2], sn[3]), cvt_pk_bf16(sn[4], sn[5]), cvt_pk_bf16(sn[6], sn[7])}; }
        for (int i = gt; i < 128 * 128; i += NT_) { const int n2 = i >> 7, k1 = i & 127; float s, c; sincospif((float)(n2 * k1) * (1.0f / 8192.0f), &s, &c); tw[i] = (f32x2){c, s}; }
    }
    {
        LAS float* scr = (LAS float*)(lds + wave * 16384);
        const int gw = vcu * 8 + wave, NGW = G * 8;
        constexpr int I_IN = 16 * 64, I_OUT = 16 * 32, I_UP = 16 * 176, I_DN = 44 * 32;
        constexpr int NITEMS = I_IN + I_OUT + 2 * I_UP + 2 * I_DN;
        for (int it = gw; it < NITEMS; it += NGW) {
            int r = it;
            if (r < I_IN) { const int kb = r / 64, nb = r % 64; const int hh = nb >> 2;
#if FUSE_QKV
                if (hh < 10 || hh == 12 || hh == 13) transpose_item<true>(a.w_in, 1024, 2048, (bf16_t*)(ws + WS_WIN), 64 * kb, 32 * nb, 32 * nb, scr, lane); else
#endif
                transpose_item(a.w_in, 1024, 2048, (bf16_t*)(ws + WS_WIN), 64 * kb, 32 * nb, 32 * nb, scr, lane); continue; } r -= I_IN;
            if (r < I_OUT) { const int kb = r / 32, nb = r % 32; transpose_item(a.w_out, 1024, 1024, (bf16_t*)(ws + WS_WOUT), 64 * kb, 32 * nb, 32 * nb, scr, lane); continue; } r -= I_OUT;
            if (r < 2 * I_UP) { const int l = r / I_UP, q = r % I_UP, kb = q / 176, nb = q % 176;
                transpose_item(a.w_up + (size_t)l * 1024 * NUP, 1024, NUP, (bf16_t*)(ws + (l ? WS_WUP1 : WS_WUP0)), 64 * kb, 32 * nb, up_row(32 * nb), scr, lane); continue; } r -= 2 * I_UP;
            { const int l = r / I_DN, q = r % I_DN, kb = q / 32, nb = q % 32;
                transpose_item(a.w_down + (size_t)l * DFF * 1024, DFF, 1024, (bf16_t*)(ws + (l ? WS_WDN1 : WS_WDN0)), 64 * kb, 32 * nb, 32 * nb, scr, lane); }
        }
    }
    {
        LAS float* cT = (LAS float*)(lds + LDS_XCH); LAS float* sT = cT + 256;
        if (tid < 256) { float s, c; sincospif((float)tid * (1.0f / 128.0f), &s, &c); cT[tid] = c; sT[tid] = s; }
        __syncthreads();
        const int gw = vcu * 8 + wave, NGW = G * 8;
        bf16_t* WP = (bf16_t*)(ws + WS_WP);
        for (int it = gw; it < 4 * 64 * 16; it += NGW) {
            const int g = it >> 10, cb = (it >> 4) & 63, nb = it & 15, n = nb * 64 + lane;
            const LAS float* tab = (cb < 32) ? cT : sT; const int cp0 = (cb & 31) * 8;
            float acc[8] = {0.f, 0.f, 0.f, 0.f, 0.f, 0.f, 0.f, 0.f};
            const float* wf = a.w_f + (size_t)(256 * g) * 1024 + n;
            for (int kb = 0; kb < 256; kb += 32) { float wv[32];
#pragma unroll
                for (int q = 0; q < 32; ++q) wv[q] = wf[(size_t)(kb + q) * 1024];
#pragma unroll
                for (int q = 0; q < 32; ++q) {
#pragma unroll
                    for (int j = 0; j < 8; ++j) acc[j] += tab[((cp0 + j) * (kb + q)) & 255] * wv[q]; } }
            const float sc = 1.0f / 2048.0f;
            u32x4 o; o.x = cvt_pk_bf16(acc[0] * sc, acc[1] * sc); o.y = cvt_pk_bf16(acc[2] * sc, acc[3] * sc); o.z = cvt_pk_bf16(acc[4] * sc, acc[5] * sc); o.w = cvt_pk_bf16(acc[6] * sc, acc[7] * sc);
#if HERM
            *(u32x4*)((bf16_t*)(ws + (cb < 32 ? WS_WC : WS_WS)) + (size_t)n * 1024 + 256 * g + (cb & 31) * 8) = o;
#else
            *(u32x4*)(WP + (size_t)n * 2048 + 512 * g + cb * 8) = o;
#endif
        }
    }
}

__device__ __forceinline__ void norm_mod_rows(const float* src, int row0, int nrows, bf16_t* XN, int xrow0, const float* g, const float* sh, const float* sc, int gw, int NGW, int lane) {
    f32x4 A[4], B[4];
#pragma unroll
    for (int j = 0; j < 4; ++j) { const int c = 4 * lane + 256 * j; const f32x4 gv = *(const f32x4*)(g + c), sv = *(const f32x4*)(sc + c); A[j] = gv * (sv + 1.0f); B[j] = *(const f32x4*)(sh + c); }
    for (int m = gw; m < nrows; m += NGW) {
        const f32x4* xr = (const f32x4*)(src + (size_t)(row0 + m) * DM) + lane;
        f32x4 v[4]; float s = 0.f;
#pragma unroll
        for (int j = 0; j < 4; ++j) { v[j] = xr[64 * j]; s += (v[j].x * v[j].x + v[j].y * v[j].y) + (v[j].z * v[j].z + v[j].w * v[j].w); }
        const float r = rsqrtf(wave_sum(s) * (1.0f / DM) + EPS);
        u32x2* o8 = (u32x2*)(XN + (size_t)(xrow0 + m) * DM) + lane;
#pragma unroll
        for (int j = 0; j < 4; ++j) { const f32x4 h = v[j] * r * A[j] + B[j]; u32x2 w; w.x = cvt_pk_bf16(h.x, h.y); w.y = cvt_pk_bf16(h.z, h.w); o8[64 * j] = w; }
    }
}

template <bool WRITE_XN, bool XIN_F32, bool XOUT_F32, bool YSYM = false>
__device__ __forceinline__ void residual_rows(const float* xin, bf16_t* XRES, const bf16_t* Y, float* xout, bf16_t* XN, int row0, int nrows, const float* gY, const float* gate, const float* gN, const float* sh, const float* sc, int gw, int NGW, int lane_in, const float* ynyq = nullptr) {
    int lane = lane_in; asm volatile("" : "+v"(lane));
    constexpr int RR = XIN_F32 ? 2 : RES_ROWS;
    f32x4 GA[4], A[4], B[4];
#pragma unroll
    for (int j = 0; j < 4; ++j) { const int c = 4 * lane + 256 * j; GA[j] = *(const f32x4*)(gY + c) * *(const f32x4*)(gate + c);
        if (WRITE_XN) { A[j] = *(const f32x4*)(gN + c) * (*(const f32x4*)(sc + c) + 1.0f); B[j] = *(const f32x4*)(sh + c); } }
    static_assert(!YSYM || RR == 2, "the mirrored-pair mapping handles two rows per trip");
    const int mstep = YSYM ? NGW : RR * NGW, mend = YSYM ? nrows / 2 : nrows;
    for (int m = gw; m < mend; m += mstep) {
        size_t ro[RR]; bool ok[RR]; f32x4 yv[RR][4]; f32x4 xv[RR][4];
#pragma unroll
        for (int q = 0; q < RR; ++q) {
            if (YSYM) { const int t = (q == 0) ? m : (m == 0 ? SEQ / 2 : SEQ - m); ok[q] = true; ro[q] = (size_t)(row0 + t) * DM; }
            else { ok[q] = (m + q * NGW) < nrows; ro[q] = (size_t)(row0 + (ok[q] ? m + q * NGW : m)) * DM; } }
        if (YSYM) { const int bq = row0 / SEQ; const size_t ru = (size_t)(bq * (SEQ / 2) + m) * DM;
#pragma unroll
            for (int j = 0; j < 4; ++j) { const u32x2 wu = ((const u32x2*)(Y + ru) + lane)[64 * j], wv = ((const u32x2*)(Y + (size_t)MTOK / 2 * DM + ru) + lane)[64 * j];
                const f32x4 uf = {bf_lo(wu.x), bf_hi(wu.x), bf_lo(wu.y), bf_hi(wu.y)}, vf = {bf_lo(wv.x), bf_hi(wv.x), bf_lo(wv.y), bf_hi(wv.y)};
                yv[0][j] = uf + vf; yv[RR - 1][j] = uf - vf;
                if (m == 0) yv[RR - 1][j] = ((const f32x4*)(ynyq + bq * 1024) + lane)[64 * j]; } }
#pragma unroll
        for (int q = 0; q < RR; ++q)
#pragma unroll
            for (int j = 0; j < 4; ++j) {
                if (YSYM) {
                } else { const u32x2 w_ = ((const u32x2*)(Y + ro[q]) + lane)[64 * j]; yv[q][j] = (f32x4){bf_lo(w_.x), bf_hi(w_.x), bf_lo(w_.y), bf_hi(w_.y)}; }
                if (XIN_F32) xv[q][j] = ((const f32x4*)(xin + ro[q]) + lane)[64 * j];
                else { const u32x2 a = ((const u32x2*)(XRES + ro[q]) + lane)[64 * j]; xv[q][j] = (f32x4){bf_lo(a.x), bf_hi(a.x), bf_lo(a.y), bf_hi(a.y)}; } }
        float s[RR];
#pragma unroll
        for (int q = 0; q < RR; ++q) { s[q] = 0.f;
#pragma unroll
            for (int j = 0; j < 4; ++j) { const f32x4 y = yv[q][j]; s[q] += (y.x * y.x + y.y * y.y) + (y.z * y.z + y.w * y.w); } }
#pragma unroll
        for (int o = 1; o < 64; o <<= 1) {
#pragma unroll
            for (int q = 0; q < RR; ++q) s[q] += __shfl_xor(s[q], o); }
        float qs[RR];
#pragma unroll
        for (int q = 0; q < RR; ++q) { const float r = rsqrtf(s[q] * (1.0f / DM) + EPS); qs[q] = 0.f;
#pragma unroll
            for (int j = 0; j < 4; ++j) { const f32x4 y = yv[q][j];
                xv[q][j] = xv[q][j] + y * r * GA[j];
                if (ok[q]) { if (XOUT_F32) ((f32x4*)(xout + ro[q]) + lane)[64 * j] = xv[q][j];
                             else { u32x2 a; a.x = cvt_pk_bf16(xv[q][j].x, xv[q][j].y); a.y = cvt_pk_bf16(xv[q][j].z, xv[q][j].w); ((u32x2*)(XRES + ro[q]) + lane)[64 * j] = a; } }
                qs[q] += (xv[q][j].x * xv[q][j].x + xv[q][j].y * xv[q][j].y) + (xv[q][j].z * xv[q][j].z + xv[q][j].w * xv[q][j].w); } }
        if (WRITE_XN) {
#pragma unroll
            for (int o = 1; o < 64; o <<= 1) {
#pragma unroll
                for (int q = 0; q < RR; ++q) qs[q] += __shfl_xor(qs[q], o); }
#pragma unroll
            for (int q = 0; q < RR; ++q) { const float t = rsqrtf(qs[q] * (1.0f / DM) + EPS);
#pragma unroll
                for (int j = 0; j < 4; ++j) { const f32x4 h = xv[q][j] * t * A[j] + B[j]; u32x2 a; a.x = cvt_pk_bf16(h.x, h.y); a.y = cvt_pk_bf16(h.z, h.w);
                    if (ok[q]) ((u32x2*)(XN + ro[q]) + lane)[64 * j] = a; } }
        }
    }
}
__device__ __forceinline__ void residual_phase(const Args& a, int l, int which, int gw, int NGW, int lane) {
    const float* MOD = (const float*)(a.ws + WS_MOD); bf16_t* XN = (bf16_t*)(a.ws + WS_XN); const bf16_t* Y = (const bf16_t*)(a.ws + WS_Y); bf16_t* XR = (bf16_t*)(a.ws + WS_XRES);
    for (int b = 0; b < NB; ++b) {
        const float* mb = MOD + (size_t)(l * 3 + b) * 6144;
        if (which == 0) {
            if (l == 0) residual_rows<true, true, false>(a.x, XR, Y, a.out, XN, b * SEQ, SEQ, a.norm_g + (l * 4 + 1) * DM, mb + 2 * DM, a.norm_g + (l * 4 + 2) * DM, mb + 3 * DM, mb + 4 * DM, gw, NGW, lane);
            else        residual_rows<true, false, false, (HERM != 0)>(a.x, XR, Y, a.out, XN, b * SEQ, SEQ, a.norm_g + (l * 4 + 1) * DM, mb + 2 * DM, a.norm_g + (l * 4 + 2) * DM, mb + 3 * DM, mb + 4 * DM, gw, NGW, lane, (const float*)(a.ws + WS_YNY));
        } else if (l == 0) { const float* mn = MOD + (size_t)(3 + b) * 6144;
            residual_rows<true, false, false>(a.x, XR, Y, a.out, XN, b * SEQ, SEQ, a.norm_g + (l * 4 + 3) * DM, mb + 5 * DM, a.norm_g + 4 * DM, mn + 0 * DM, mn + 1 * DM, gw, NGW, lane); }
        else residual_rows<false, false, true>(a.x, XR, Y, a.out, XN, b * SEQ, SEQ, a.norm_g + (l * 4 + 3) * DM, mb + 5 * DM, nullptr, nullptr, nullptr, gw, NGW, lane);
    }
}

__device__ __forceinline__ void qkv_post(const Args& a, int m_lo, int m_hi, int gw, int NGW, int lane, int jsel, int halfsel) {
    const bf16_t* PROJ = (const bf16_t*)(a.ws + WS_PROJ); bf16_t* Q = (bf16_t*)(a.ws + WS_Q);
    const f32x2* rope = (const f32x2*)(a.ws + WS_ROPE);
    const int l16 = lane & 15, d0 = 8 * l16, ax = l16 >> 3, half = (l16 >> 2) & 1, f0 = 8 * (lane & 3);
    float qg[8], kg[8];
#pragma unroll
    for (int e = 0; e < 8; ++e) { qg[e] = a.q_g[d0 + e]; kg[e] = a.k_g[d0 + e]; }
    u32x4 nx[4]; f32x4 nrp[4];
#define QKV_PREFETCH(ROW) do { const int m_ = (ROW); const bool ic_ = m_ >= MTOK; const int t_ = ic_ ? ((m_ - MTOK) & 255) : (m_ & (SEQ - 1)); const int pos_ = ax ? (t_ & 63) : (t_ >> 6); \
        _Pragma("unroll") for (int e = 0; e < 4; ++e) nrp[e] = *(const f32x4*)(rope + pos_ * 32 + f0 + 2 * e); \
        _Pragma("unroll") for (int j = 0; j < 4; ++j) nx[j] = *(const u32x4*)(PROJ + (size_t)m_ * NPROJ + 512 * j + 8 * lane); } while (0)
    if (m_lo + gw < m_hi) QKV_PREFETCH(m_lo + gw);
    for (int m = m_lo + gw; m < m_hi; m += NGW) {
        u32x4 cur[4]; f32x4 crp[4];
#pragma unroll
        for (int j = 0; j < 4; ++j) { cur[j] = nx[j]; crp[j] = nrp[j]; }
        if (m + NGW < m_hi) QKV_PREFETCH(m + NGW);
        const bool isctx = m >= MTOK; const int b = isctx ? ((m - MTOK) >> 8) : (m >> 14); const int t = isctx ? ((m - MTOK) & 255) : (m & (SEQ - 1));
        const int pos = ax ? (t & 63) : (t >> 6);
        float cs[8], sn[8];
#pragma unroll
        for (int e = 0; e < 4; ++e) { cs[2 * e] = crp[e].x; sn[2 * e] = crp[e].y; cs[2 * e + 1] = crp[e].z; sn[2 * e + 1] = crp[e].w; }
#pragma unroll
        for (int j = 0; j < 4; ++j) {
            if ((isctx && j < 2) || (jsel >= 0 && j != jsel)) continue;
            const u32x4 w = cur[j];
            float x[8] = {bf_lo(w.x), bf_hi(w.x), bf_lo(w.y), bf_hi(w.y), bf_lo(w.z), bf_hi(w.z), bf_lo(w.w), bf_hi(w.w)};
            const int hh = 4 * j + (lane >> 4);
            float ss = 0.f;
#pragma unroll
            for (int e = 0; e < 8; ++e) ss += x[e] * x[e];
            ss += __shfl_xor(ss, 1); ss += __shfl_xor(ss, 2); ss += __shfl_xor(ss, 4); ss += __shfl_xor(ss, 8);
            const float r = rsqrtf(ss * (1.0f / HD) + EPS);
            const bool isq = hh < 4, isk = (hh == 8 || hh == 9);
            if (isq || isk) {
#pragma unroll
                for (int e = 0; e < 8; ++e) x[e] = x[e] * r * (isq ? qg[e] : kg[e]); }
            const bool dorope = !isctx && (hh < 10 || hh == 12 || hh == 13);
#pragma unroll
            for (int e = 0; e < 8; ++e) { const float p = __shfl_xor(x[e], 4); const float rot = half ? (x[e] * cs[e] + p * sn[e]) : (x[e] * cs[e] - p * sn[e]); if (dorope) x[e] = rot; }
            u32x4 o; o.x = cvt_pk_bf16(x[0], x[1]); o.y = cvt_pk_bf16(x[2], x[3]); o.z = cvt_pk_bf16(x[4], x[5]); o.w = cvt_pk_bf16(x[6], x[7]);
            bf16_t* dst;
            if (hh < 8) dst = Q + (size_t)m * DM + hh * HD + d0;
            else { const int sel = (hh - 8) >> 1, kvh = (hh - 8) & 1; dst = (bf16_t*)(a.ws + WS_KA + (size_t)sel * KV_BYTES) + ((size_t)(b * 2 + kvh) * SKV + (isctx ? t : CTXL + t)) * HD + d0; }
            if (halfsel < 0 || (lane >> 5) == halfsel) *(u32x4*)dst = o;
        }
    }
#undef QKV_PREFETCH
}

__device__ __forceinline__ void ctx_tile_post(const Args& a, int b, int pn, int wave, int lane) {
    const bf16_t* __restrict__ PROJ = (const bf16_t*)(a.ws + WS_PROJ);
    bf16_t* __restrict__ KVb = (bf16_t*)(a.ws + WS_KA + (size_t)(pn - 4) * KV_BYTES);
    const int l32 = lane & 31, head = l32 >> 4, d0 = 8 * (l32 & 15), c0 = 1024 + 256 * (pn - 4);
    float kg[8];
#pragma unroll
    for (int e = 0; e < 8; ++e) kg[e] = (pn == 4) ? a.k_g[d0 + e] : 1.0f;
#pragma unroll 4
    for (int i = 0; i < 16; ++i) {
        const int r = wave * 32 + 2 * i + (lane >> 5); const size_t m = (size_t)MTOK + 256 * b + r;
        const u32x4 w = *(const u32x4*)(PROJ + m * NPROJ + c0 + 8 * l32);
        float x[8] = {bf_lo(w.x), bf_hi(w.x), bf_lo(w.y), bf_hi(w.y), bf_lo(w.z), bf_hi(w.z), bf_lo(w.w), bf_hi(w.w)};
        float ss = 0.f;
#pragma unroll
        for (int e = 0; e < 8; ++e) ss += x[e] * x[e];
        ss += __shfl_xor(ss, 1); ss += __shfl_xor(ss, 2); ss += __shfl_xor(ss, 4); ss += __shfl_xor(ss, 8);
        const float rn = (pn == 4) ? rsqrtf(ss * (1.0f / HD) + EPS) : 1.0f;
#pragma unroll
        for (int e = 0; e < 8; ++e) x[e] = x[e] * rn * kg[e];
        u32x4 o; o.x = cvt_pk_bf16(x[0], x[1]); o.y = cvt_pk_bf16(x[2], x[3]); o.z = cvt_pk_bf16(x[4], x[5]); o.w = cvt_pk_bf16(x[6], x[7]);
        *(u32x4*)(KVb + ((size_t)(b * 2 + head) * SKV + r) * HD + d0) = o;
    }
}

#ifndef PH
#define PH 0xFFFF
#endif
typedef unsigned gu32_unused_t;
#define RLX_AGENT __ATOMIC_RELAXED, __HIP_MEMORY_SCOPE_AGENT
#define XB_TMO      128
#define XB_XCNT(j)  (256  + 64 * (j))
#define XB_XSUB(j)  (1280 + 64 * (j))
#define XB_XGEN(j)  (2304 + 64 * (j))
#define XB_TOP      3328
#define XB_TOPGEN   3392
#define XCD_BAR_WORDS 3456
#define XB_SPIN_CAP (1u << 18)

__device__ __forceinline__ unsigned xb_ld(unsigned* p)              { return __hip_atomic_load(p, __ATOMIC_RELAXED, __HIP_MEMORY_SCOPE_AGENT); }
__device__ __forceinline__ unsigned xb_add(unsigned* p, unsigned v) { return __hip_atomic_fetch_add(p, v, __ATOMIC_RELAXED, __HIP_MEMORY_SCOPE_AGENT); }
__device__ __forceinline__ unsigned xb_xcc_id() { return (unsigned)__builtin_amdgcn_s_getreg((3 << 11) | 20) & 0xFu; }
#define XB_SPIN(cond, bar) do { unsigned _sp = 0; while (cond) { __builtin_amdgcn_s_sleep(1); \
    if ((++_sp & 255u) == 0u) { if (xb_ld(&(bar)[XB_TMO])) break; if (_sp > XB_SPIN_CAP) { atomicAdd(&(bar)[XB_TMO], 1u); break; } } } } while (0)

struct XcdBarrier {
    unsigned* bar; unsigned x;
    volatile LAS unsigned* st;
};

__device__ __forceinline__ XcdBarrier xcd_barrier_post(unsigned* bar, volatile LAS unsigned* st, bool t0) {
    XcdBarrier b; b.bar = bar; b.x = xb_xcc_id(); b.st = st;
    if (t0) (void)xb_add(&bar[XB_XCNT(b.x)], 1u);
    return b;
}
__device__ __forceinline__ void xcd_barrier_complete(unsigned* bar, unsigned x, unsigned& nloc, unsigned& nx) {
    const unsigned G = gridDim.x * gridDim.y * gridDim.z;
    unsigned sum, cnt, mine, sp = 0u;
    for (;;) {
        sum = 0u; cnt = 0u; mine = 0u;
#pragma unroll
        for (unsigned j = 0; j < 16; ++j) { const unsigned c = xb_ld(&bar[XB_XCNT(j)]); sum += c; cnt += (c > 0u) ? 1u : 0u; mine = (j == x) ? c : mine; }
        if (sum == G) break;
        __builtin_amdgcn_s_sleep(1);
        if ((++sp & 255u) == 0u) { if (xb_ld(&bar[XB_TMO])) break; if (sp > XB_SPIN_CAP) { atomicAdd(&bar[XB_TMO], 1u); break; } }
    }
    nloc = mine > 0u ? mine : 1u; nx = cnt > 0u ? cnt : 1u;
}

__device__ __forceinline__ void xcd_barrier(const XcdBarrier& b, int wave_s) {
    asm volatile("s_waitcnt vmcnt(0)" ::: "memory");
    __syncthreads();
    int l0_ = 1; if (wave_s == 0) asm volatile("v_mbcnt_lo_u32_b32 %0, -1, 0" : "=v"(l0_));
    if (wave_s == 0 && l0_ == 0) {
        unsigned* bar = b.bar;
        __builtin_amdgcn_s_waitcnt(0);
        unsigned nloc = b.st[0], nx = b.st[1];
        if (nloc == 0u) { xcd_barrier_complete(bar, b.x, nloc, nx); b.st[0] = nloc; b.st[1] = nx; }
        const unsigned old = xb_add(&bar[XB_XSUB(b.x)], 1u);
        const unsigned gen = old / nloc;
        if (old + 1u == (gen + 1u) * nloc) {
            __builtin_amdgcn_fence(__ATOMIC_RELEASE, "agent");
            asm volatile("s_waitcnt vmcnt(0)" ::: "memory");
            const unsigned og = xb_add(&bar[XB_TOP], 1u);
            const unsigned tg = og / nx;
            if (og + 1u == (tg + 1u) * nx) xb_add(&bar[XB_TOPGEN], 1u);
            else XB_SPIN(xb_ld(&bar[XB_TOPGEN]) == tg, bar);
            __builtin_amdgcn_fence(__ATOMIC_ACQUIRE, "agent");
            xb_add(&bar[XB_XGEN(b.x)], 1u);
            asm volatile("s_waitcnt vmcnt(0)" ::: "memory");
        } else {
            XB_SPIN(xb_ld(&bar[XB_XGEN(b.x)]) == gen, bar);
            __builtin_amdgcn_fence(__ATOMIC_ACQUIRE, "agent");
            asm volatile("s_waitcnt vmcnt(0)" ::: "memory");
        }
    }
    __syncthreads();
}


#define GRID_SEAM() xcd_barrier(xbar, wave_s)
#define PHASE_PRELUDE \
        int tid_o; asm volatile("v_mbcnt_lo_u32_b32 %0, -1, 0\n\tv_mbcnt_hi_u32_b32 %0, -1, %0\n\tv_add_u32 %0, %1, %0" : "=&v"(tid_o) : "s"(wave_s * 64)); \
        int vcu = vcu0; asm volatile("" : "+s"(vcu)); \
        const int tid = tid_o, lane = tid & 63, wave = tid >> 6, gw = vcu * 8 + wave; (void)tid; \
        const Args& a = a_k; unsigned char* ws = a.ws; \
        const float* MOD = (const float*)(ws + WS_MOD); bf16_t* XN = (bf16_t*)(ws + WS_XN); bf16_t* Y = (bf16_t*)(ws + WS_Y);
__global__ void __launch_bounds__(512, 2) fwd_megakernel(Args a_k) {
    extern __shared__ __attribute__((aligned(16))) unsigned char ldsraw[];
    cg::grid_group grid = cg::this_grid();
    LAS unsigned char* lds = (LAS unsigned char*)ldsraw;
    const int G = gridDim.x; const int bx = blockIdx.x; const int vcu0 = (G % 8 == 0) ? (bx % 8) * (G / 8) + bx / 8 : bx;
    const int NGW = G * 8;
    const int wave_s = __builtin_amdgcn_readfirstlane((int)threadIdx.x >> 6);
    { volatile LAS unsigned* st0 = (volatile LAS unsigned*)(lds + LDS_MISC); if (threadIdx.x < 2) st0[threadIdx.x] = 0u; }
    __syncthreads();
    const XcdBarrier xbar = xcd_barrier_post((unsigned*)(a_k.ws + WS_CTL), (volatile LAS unsigned*)(lds + LDS_MISC), threadIdx.x == 0);
    constexpr int NPH = 17;
#pragma nounroll
    for (int ph = 0; ph < NPH; ++ph) {
        const int kinds = (ph == 0) ? 0 : (ph == 1) ? 1 : (ph == 3) ? 3 : (ph == 4) ? 4 : (ph == 10) ? 7 : (ph == 11) ? 8 : (ph == 7 || ph == 14) ? 6 : (ph == 6 || ph == 9 || ph == 13 || ph == 16) ? 5 : 2;
#ifdef EXPMASK
        const int reps = ((EXPMASK >> ph) & 1) ? 2 : 1;
#else
        const int reps = 1;
#endif
#if FUSE_QKV
        if (ph == 3) continue;
#endif
#pragma nounroll
        for (int rep = 0; rep < reps; ++rep) {
        if (rep) __syncthreads();
#if FUSE_QKV
        if (ph == 2) { PHASE_PRELUDE
            pg8::Gemm g{XN, (const bf16_t*)(ws + WS_WIN), 1024, 256}; pg8::StaticOrder S; S.init(MALL / 256, NPROJ / 256, G, bx);
            pg8::EpiQKV E{(bf16_t*)(ws + WS_Q), (bf16_t*)(ws + WS_KA), a.q_g, a.k_g, (const f32x2*)(ws + WS_ROPE), lds + LDS_XCH};
            pg8::gemm_phase<pg8::EpiQKV, pg8::StaticOrder, true, true>(lds, g, S, E, tid);
        } else
#endif
        if (kinds == 0) { PHASE_PRELUDE
#if PH & 1
            prologue(a, vcu, G, ldsraw, lds, tid);
#endif
        } else if (kinds == 1) { PHASE_PRELUDE
#if PH & 2
            for (int b = 0; b < NB; ++b) norm_mod_rows(a.x, b * SEQ, SEQ, XN, b * SEQ, a.norm_g, MOD + (size_t)b * 6144, MOD + (size_t)b * 6144 + DM, gw, NGW, lane);
            norm_mod_rows(a.ctx, 0, NB * CTXL, XN, MTOK, a.norm_g, MOD + (size_t)2 * 6144, MOD + (size_t)2 * 6144 + DM, gw, NGW, lane);
#endif
        } else if (kinds == 2 || (CTX_IN_P3 && ph == 3 && bx < 8)) { PHASE_PRELUDE
#if PH & 4
            const bf16_t* A; const bf16_t* Bt; bf16_t* O; int K, nM, nN, ldc;
            if (ph == 2 || ph == 3) { A = XN; Bt = (const bf16_t*)(ws + WS_WIN); O = (bf16_t*)(ws + WS_PROJ); K = 1024; nM = (CTX_IN_P3 && ph == 2) ? MTOK / 256 : MALL / 256; nN = NPROJ / 256; ldc = NPROJ; }
            else if (ph == 5)  { A = (const bf16_t*)(ws + WS_O); Bt = (const bf16_t*)(ws + WS_WOUT); O = Y; K = 1024; nM = MTOK / 256; nN = 4; ldc = DM; }
#if HERM
            else if (ph == 12) { A = (const bf16_t*)(ws + WS_XR); Bt = (const bf16_t*)(ws + WS_WC); O = Y; K = 1024; nM = MTOK / 256; nN = 4; ldc = DM; }
#else
            else if (ph == 12) { A = (const bf16_t*)(ws + WS_A2); Bt = (const bf16_t*)(ws + WS_WP); O = Y; K = 2048; nM = MTOK / 256; nN = 4; ldc = DM; }
#endif
            else               { A = (const bf16_t*)(ws + WS_ACT); Bt = (const bf16_t*)(ws + (ph == 15 ? WS_WDN1 : WS_WDN0)); O = Y; K = DFF; nM = MTOK / 256; nN = 4; ldc = DM; }
            pg8::Gemm g{A, Bt, K, 256}; pg8::StaticOrder S; S.init(nM, nN, G, bx);
            if (ph == 3) { S.fpm = MTOK / 256 + (bx >> 2); S.fpn = 4 + (bx & 3); }
#if HERM
            if (ph == 12) { g.msplit = 64; g.bsplit = (size_t)(WS_WS - WS_WC); }
#endif
#if CONV_ALIGNED
            if (ph == 8 || ph == 15) {
                const int l = (ph == 15) ? 1 : 0; const float* cw = a.conv_w + (size_t)l * 3 * NUP; const float* cb = a.conv_b + (size_t)l * NUP;
                const bf16_t* ED = (const bf16_t*)(ws + WS_EDGE); bf16_t* ACTp = (bf16_t*)(ws + WS_ACT);
                pg8::Unit uu;
                for (int i = 0; S.next(i, uu); ++i) {
                    const int pm = uu.pm;
                    for (int q = tid; q < 2 * DFF; q += 512) { const int side = q >= DFF ? 1 : 0, j = q - side * DFF; const int R = 256 * pm + (side ? 255 : 0);
                        const bool cut = side ? ((R & (SEQ - 1)) == SEQ - 1) : ((R & (SEQ - 1)) == 0);
                        const bf16_t* ep = side ? ED + ((size_t)pm * 4 + 2) * NUP : ED + ((size_t)(cut ? pm : pm - 1) * 4 + 3) * NUP;
                        const bf16_t* ec = ED + ((size_t)pm * 4 + (side ? 3 : 0)) * NUP;
                        const bf16_t* en = side ? ED + ((size_t)(cut ? pm : pm + 1) * 4 + 0) * NUP : ED + ((size_t)pm * 4 + 1) * NUP;
                        float uv[2];
#pragma unroll
                        for (int h = 0; h < 2; ++h) { const int c = h * DFF + j;
                            float vp = bf_lo((unsigned)ep[c]), vc = bf_lo((unsigned)ec[c]), vn = bf_lo((unsigned)en[c]);
                            if (cut) { if (side) vn = 0.f; else vp = 0.f; }
                            uv[h] = cw[c] * vp + cw[NUP + c] * vc + cw[2 * NUP + c] * vn + cb[c]; }
                        const float sg = __builtin_amdgcn_rcpf(1.0f + __builtin_amdgcn_exp2f(-1.4426950408889634f * uv[0]));
                        ACTp[(size_t)R * DFF + j] = f2bf(uv[0] * sg * uv[1]); }
                }
                asm volatile("s_waitcnt vmcnt(0)" ::: "memory"); __syncthreads();
            }
#endif
            pg8::EpiBf16 E{O, ldc};
            pg8::gemm_phase<pg8::EpiBf16, pg8::StaticOrder, false, true>(lds, g, S, E, tid);
#if HERM
            if (ph == 12) {
                const float* XNY = (const float*)(ws + WS_YNY) + 2048; float* YNY = (float*)(ws + WS_YNY); const bf16_t* WC = (const bf16_t*)(ws + WS_WC);
                for (int o = gw; o < NB * 1024; o += NGW) { const int b = o >> 10, n = o & 1023;
                    const f32x4* xp = (const f32x4*)(XNY + b * 1024 + lane * 16); const u32x4* wp = (const u32x4*)(WC + (size_t)n * 1024 + lane * 16);
                    const f32x4 x0 = xp[0], x1 = xp[1], x2 = xp[2], x3 = xp[3]; const u32x4 w0 = wp[0], w1 = wp[1];
                    float acc_ = x0[0] * bf_lo(w0.x) + x0[1] * bf_hi(w0.x) + x0[2] * bf_lo(w0.y) + x0[3] * bf_hi(w0.y) + x1[0] * bf_lo(w0.z) + x1[1] * bf_hi(w0.z) + x1[2] * bf_lo(w0.w) + x1[3] * bf_hi(w0.w)
                               + x2[0] * bf_lo(w1.x) + x2[1] * bf_hi(w1.x) + x2[2] * bf_lo(w1.y) + x2[3] * bf_hi(w1.y) + x3[0] * bf_lo(w1.z) + x3[1] * bf_hi(w1.z) + x3[2] * bf_lo(w1.w) + x3[3] * bf_hi(w1.w);
#pragma unroll
                    for (int o_ = 1; o_ < 64; o_ <<= 1) acc_ += __shfl_xor(acc_, o_);
                    if (lane == 0) YNY[b * 1024 + n] = acc_; }
            }
#endif
#endif
        } else if (kinds == 3) {
        } else if (kinds == 4) { PHASE_PRELUDE
#if PH & 16
#if ATT_FIXMAX
            float sbound; bool usefix;
            { float mq = fmaxf(fabsf(a.q_g[lane]), fabsf(a.q_g[64 + lane])), mk = fmaxf(fabsf(a.k_g[lane]), fabsf(a.k_g[64 + lane]));
#pragma unroll
              for (int o_ = 1; o_ < 64; o_ <<= 1) { mq = fmaxf(mq, __shfl_xor(mq, o_)); mk = fmaxf(mk, __shfl_xor(mk, o_)); }
              sbound = 11.313708499f * mq * mk * 1.03f + 0.05f; usefix = sbound < 30.0f; }
#endif
#define GLOBAL_UNITS(CALL) for (int u = vcu; u < 512; u += G) { const int b = u >> 8, h = (u >> 6) & 3, qb = u & 63; \
                bf16_t* Qp = (bf16_t*)(ws + WS_Q) + ((size_t)(b * SEQ + qb * 256)) * DM + h * HD; \
                const bf16_t* Kp = (const bf16_t*)(ws + WS_KA) + (size_t)(b * 2 + (h >> 1)) * SKV * HD; const bf16_t* Vp = Kp + KV_BYTES / 2; \
                bf16_t* Op = (bf16_t*)(ws + WS_O) + (Qp - (bf16_t*)(ws + WS_Q)); CALL; }
#if ATT_FIXMAX
            if (usefix) { GLOBAL_UNITS((att::attn_unit<false, true>(Qp, Kp, Vp, Op, SKV / 64, 0, 0, sbound, 0.f, (char*)ldsraw, tid))); }
            else
#endif
            { GLOBAL_UNITS((att::attn_unit<false, false>(Qp, Kp, Vp, Op, SKV / 64, 0, 0, -1e30f, 0.f, (char*)ldsraw, tid))); }
#undef GLOBAL_UNITS
#endif
#if PH & 32
            for (int u = vcu; u < 512; u += G) {
                const int b = u >> 8, h = (u >> 6) & 3, qb = u & 63;
                bf16_t* Qp = (bf16_t*)(ws + WS_Q) + ((size_t)(b * SEQ + qb * 256)) * DM + 512 + h * HD;
                const bf16_t* Kp = (const bf16_t*)(ws + WS_KB) + (size_t)(b * 2 + (h >> 1)) * SKV * HD; const bf16_t* Vp = Kp + KV_BYTES / 2;
                const int q0 = qb * 256; const int lo_tok = (q0 == 0) ? 0 : q0 - 128; const int nloc = (q0 == 0 || q0 == SEQ - 256) ? 6 : 8;
                att::attn_unit<true>(Qp, Kp, Vp, (bf16_t*)(ws + WS_O) + (Qp - (bf16_t*)(ws + WS_Q)), 4 + nloc, CTXL + lo_tok, lo_tok - q0, a.sink[h] / att::SCALE, 1.f, (char*)ldsraw, tid);
            }
#endif
        } else if (kinds == 5) { PHASE_PRELUDE
#if PH & 64
            const int l = (ph >= 13) ? 1 : 0, which = (ph == 9 || ph == 16) ? 1 : 0;
            residual_phase(a, l, which, gw, NGW, lane);
#endif
        } else if (kinds == 6) { PHASE_PRELUDE
#if PH & 512
            const int l = (ph == 14) ? 1 : 0;
#if CONV_ALIGNED
            pg8::Gemm g{XN, (const bf16_t*)(ws + (l ? WS_WUP1 : WS_WUP0)), 1024, 256}; pg8::StaticOrder S; S.init(MTOK / 256, NUP / 256, G, bx);
#else
            pg8::Gemm g{XN - DM, (const bf16_t*)(ws + (l ? WS_WUP1 : WS_WUP0)), 1024, 254}; pg8::StaticOrder S; S.init(NTILE_UP, NUP / 256, G, bx);
#endif
            pg8::EpiConvGate E{(bf16_t*)(ws + WS_ACT), a.conv_w + (size_t)l * 3 * NUP, a.conv_b + (size_t)l * NUP, lds + LDS_XCH, (bf16_t*)(ws + WS_EDGE)};
            pg8::gemm_phase<pg8::EpiConvGate, pg8::StaticOrder, true, true>(lds, g, S, E, tid);
#endif
        } else if (kinds == 7) { PHASE_PRELUDE
#if PH & 128
            att::dft_phase<1>(XN, nullptr, (bf16_t*)(ws + WS_Y1R), (bf16_t*)(ws + WS_Y1I), (const f32x2*)(ws + WS_TW), (const bf16x8*)(ws + WS_DFTW), vcu, G, (char*)ldsraw, tid);
#endif
        } else { PHASE_PRELUDE
#if PH & 256
#if HERM
            {
                LAS float* red = (LAS float*)(lds + LDS_XCH); float* XNY = (float*)(ws + WS_YNY) + 2048; const bf16_t* Y1R = (const bf16_t*)(ws + WS_Y1R);
                for (int item = vcu; item < NB * 128; item += G) { const int b = item >> 7, cg8 = (item & 127) * 8; const int n2 = tid >> 2, cp = tid & 3;
                    const unsigned e = *(const unsigned*)(Y1R + ((size_t)b * SEQ + n2) * DM + cg8 + 2 * cp); const float sg = (n2 & 1) ? -1.0f : 1.0f;
                    red[(n2 * 4 + cp) * 2] = sg * bf_lo(e); red[(n2 * 4 + cp) * 2 + 1] = sg * bf_hi(e);
                    __syncthreads();
                    if (tid < 8) { float s_ = 0.f; for (int r = 0; r < 128; ++r) s_ += red[r * 8 + tid]; XNY[b * 1024 + cg8 + tid] = s_; }
                    __syncthreads(); }
            }
#endif
            att::dft_phase<2>((const bf16_t*)(ws + WS_Y1R), (const bf16_t*)(ws + WS_Y1I), (bf16_t*)(ws + (HERM ? WS_XR : WS_A2)), (bf16_t*)(ws + WS_XI), nullptr, (const bf16x8*)(ws + WS_DFTW), vcu, G, (char*)ldsraw, tid);
#endif
        }
        if (kinds == 3) { PHASE_PRELUDE
#if PH & 8
            if (CTX_IN_P3) {
                if (bx < 8) { asm volatile("s_waitcnt vmcnt(0)" ::: "memory"); __syncthreads();
                    ctx_tile_post(a, bx >> 2, 4 + (bx & 3), wave, lane); }
                else qkv_post(a, 0, MTOK, (bx - 8) * 8 + wave, (G - 8) * 8, lane, -1, -1);
            } else qkv_post(a, 0, MALL, gw, NGW, lane, -1, -1);
#endif
        }
        }
#ifdef DBG_STOP
        if (ph == DBG_STOP) { PHASE_PRELUDE
            asm volatile("s_waitcnt vmcnt(0)" ::: "memory"); __syncthreads();
            if (wave_s == 0) { __builtin_amdgcn_fence(__ATOMIC_RELEASE, "agent"); asm volatile("s_waitcnt vmcnt(0)" ::: "memory"); }
            grid.sync();
            __builtin_amdgcn_fence(__ATOMIC_ACQUIRE, "agent"); asm volatile("s_waitcnt vmcnt(0)" ::: "memory");
            const bf16_t* buf = (const bf16_t*)(ws + DBG_BUF); const int ld = DBG_LD;
            for (size_t i = (size_t)bx * 512 + tid; i < (size_t)MTOK * DM; i += (size_t)G * 512) { const size_t r = i >> 10; const int c = (int)(i & 1023); float acc = 0.f;
                for (int j = 0; c + 1024 * j < ld; ++j) acc += bf_lo((unsigned)buf[r * ld + c + 1024 * j]);
#ifdef DBG_ADD_OUT
                acc += a.out[i];
#endif
                a.out[i] = acc; }
            return;
        }
#endif
#ifdef EXTRA_SEAMS
        if (ph == 5) { for (int es = 0; es < EXTRA_SEAMS; ++es) GRID_SEAM(); }
#endif
        if (gridDim.x > 0x40000000u) grid.sync();
        if (ph + 1 < NPH) {
            GRID_SEAM();
        }
    }
}

extern "C" void kernel_launch(void* const* d_in, const int* in_sizes, int n_in, void* d_out, int out_size, void* d_ws, size_t ws_size, hipStream_t stream) {
    static int grid = 0;
    if (grid == 0) {
        if (n_in != 17 || in_sizes[0] != MTOK * DM || out_size != MTOK * DM || ws_size < WS_END) { fprintf(stderr, "kernel_launch: unexpected shapes (n_in %d, in0 %d, out %d, ws %zu)\n", n_in, n_in > 0 ? in_sizes[0] : -1, out_size, ws_size); grid = -1; return; }
        int dev = 0, cus = 0, per_cu = 0;
        hipGetDevice(&dev); hipDeviceGetAttribute(&cus, hipDeviceAttributeMultiprocessorCount, dev);
        if (hipFuncSetAttribute((const void*)fwd_megakernel, hipFuncAttributeMaxDynamicSharedMemorySize, LDS_BYTES) != hipSuccess) { fprintf(stderr, "kernel_launch: hipFuncSetAttribute failed\n"); grid = -1; return; }
        if (hipOccupancyMaxActiveBlocksPerMultiprocessor(&per_cu, (const void*)fwd_megakernel, 512, LDS_BYTES) != hipSuccess || per_cu < 1) { fprintf(stderr, "kernel_launch: occupancy query gave %d\n", per_cu); per_cu = 1; }
        (void)hipGetLastError();
        grid = cus;
    }
    if (grid < 0) return;
    Args a{};
    a.x = (const float*)d_in[0]; a.c = (const float*)d_in[1]; a.ctx = (const float*)d_in[2]; a.c_ctx = (const float*)d_in[3]; a.mod_w = (const float*)d_in[4]; a.mod_b = (const float*)d_in[5];
    a.norm_g = (const float*)d_in[6]; a.w_in = (const float*)d_in[7]; a.w_out = (const float*)d_in[8]; a.q_g = (const float*)d_in[9]; a.k_g = (const float*)d_in[10]; a.sink = (const float*)d_in[11];
    a.w_f = (const float*)d_in[12]; a.w_up = (const float*)d_in[13]; a.conv_w = (const float*)d_in[14]; a.conv_b = (const float*)d_in[15]; a.w_down = (const float*)d_in[16];
    a.out = (float*)d_out; a.ws = (unsigned char*)d_ws;
    if (hipMemsetAsync((char*)d_ws + WS_CTL, 0, 16384, stream) != hipSuccess) { fprintf(stderr, "kernel_launch: hipMemsetAsync failed\n"); return; }
    void* args[] = {&a};
    hipError_t e = hipLaunchCooperativeKernel((const void*)fwd_megakernel, dim3(grid), dim3(512), args, LDS_BYTES, stream);
    if (e != hipSuccess) fprintf(stderr, "kernel_launch: cooperative launch failed: %s (grid %d)\n", hipGetErrorString(e), grid);
}
```
